# Optimizing an MI355X kernel written in HIP

```python
import math
import jax, jax.numpy as jnp
from jax import lax
import numpy as np

D_MODEL = 1024
BATCH = 8
SEQ = 4096
DEPTH = 2

HEAD_DIM = 64
BLOCK = 128
A_HEADS = 4
A_QK = 2 * HEAD_DIM
A_V = 2 * HEAD_DIM
A_WIDTH = A_HEADS * A_V
B_HEADS = 4
B_KV = 2
WINDOW = 128
B_WIDTH = B_HEADS * HEAD_DIM
C_HEADS = 4
C_KV = 2
C_WIDTH = C_HEADS * HEAD_DIM
GRID_W = 64
ROPE_THETA = 10000.0
MIX_WIDTH = A_WIDTH + B_WIDTH + C_WIDTH
SPLIT_SIZES = (A_HEADS * A_QK, A_HEADS * A_QK, A_HEADS * A_V,
               B_HEADS * HEAD_DIM, B_KV * HEAD_DIM, B_KV * HEAD_DIM,
               C_HEADS * HEAD_DIM, C_KV * HEAD_DIM, C_KV * HEAD_DIM)
IN_WIDTH = sum(SPLIT_SIZES)
D_FF = 4 * D_MODEL
EPS = 1e-6
N_ALIBI = A_HEADS + B_HEADS
ALIBI_SLOPES = tuple(2.0 ** (-8.0 * (i + 1) / N_ALIBI) for i in range(N_ALIBI))
A_SLOPES = ALIBI_SLOPES[0::2]
B_SLOPES = ALIBI_SLOPES[1::2]

kernel_name = "hybrid_parallel_diff_window_axial_encoder"


def _split_points():
    pts, acc = [], 0
    for s in SPLIT_SIZES[:-1]:
        acc += s
        pts.append(acc)
    return pts


def rms_norm(x, g):
    xf = x.astype(jnp.float32)
    y = xf * lax.rsqrt(jnp.mean(xf * xf, axis=-1, keepdims=True) + EPS)
    return (y * g.astype(jnp.float32)).astype(x.dtype)


def diff_attention(q, k, v, lam, lam_init, subln_g):
    bsz, s_len = q.shape[0], q.shape[1]
    nb = s_len // BLOCK
    scale = HEAD_DIM ** -0.5
    slopes = jnp.asarray(A_SLOPES, dtype=jnp.float32)
    kpos = jnp.arange(s_len)
    qb = q.reshape(bsz, nb, BLOCK, A_HEADS, 2, HEAD_DIM).transpose(1, 0, 2, 3, 4, 5)

    def block(args):
        qi, i = args
        sc = jnp.einsum('bqhcd,bshcd->bchqs', qi, k).astype(jnp.float32) * scale
        qpos = i * BLOCK + jnp.arange(BLOCK)
        dist = jnp.abs(qpos[:, None] - kpos[None, :]).astype(jnp.float32)
        sc = sc - slopes[:, None, None] * dist[None]
        p = jax.nn.softmax(sc, axis=-1)
        attn = p[:, 0] - lam * p[:, 1]
        return jnp.einsum('bhqs,bshe->bqhe', attn.astype(v.dtype), v)

    o = lax.map(block, (qb, jnp.arange(nb)))
    o = o.transpose(1, 0, 2, 3, 4).reshape(bsz, s_len, A_HEADS, A_V)
    o = rms_norm(o, subln_g) * (1.0 - lam_init)
    return o.reshape(bsz, s_len, A_WIDTH)


def window_attention(q, k, v, sink):
    bsz, s_len = q.shape[0], q.shape[1]
    nb = s_len // BLOCK
    grp = B_HEADS // B_KV
    scale = HEAD_DIM ** -0.5
    qb = q.reshape(bsz, nb, BLOCK, B_KV, grp, HEAD_DIM)

    def band(t):
        tp = jnp.pad(t, ((0, 0), (BLOCK, BLOCK), (0, 0), (0, 0)))
        tb = tp.reshape(bsz, nb + 2, BLOCK, B_KV, HEAD_DIM)
        return jnp.concatenate([tb[:, :-2], tb[:, 1:-1], tb[:, 2:]], axis=2)

    kw, vw = band(k), band(v)
    sc = jnp.einsum('bnqkgd,bnskd->bnkgqs', qb, kw).astype(jnp.float32) * scale
    j = jnp.arange(3 * BLOCK)
    a = jnp.arange(BLOCK)
    delta = j[None, :] - BLOCK - a[:, None]
    spos = jnp.arange(nb)[:, None] * BLOCK - BLOCK + j[None, :]
    mask = (jnp.abs(delta) <= WINDOW)[None] & ((spos >= 0) & (spos < s_len))[:, None, :]
    slopes = jnp.asarray(B_SLOPES, dtype=jnp.float32).reshape(B_KV, grp)
    bias = -slopes[:, :, None, None] * jnp.abs(delta).astype(jnp.float32)[None, None]
    sc = jnp.where(mask[None, :, None, None], sc + bias[None, None], -jnp.inf)
    sk = jnp.broadcast_to(sink.astype(jnp.float32).reshape(B_KV, grp)[None, None, :, :, None, None],
                          sc.shape[:-1] + (1,))
    p = jax.nn.softmax(jnp.concatenate([sc, sk], axis=-1), axis=-1)[..., :-1]
    o = jnp.einsum('bnkgqs,bnskd->bnqkgd', p.astype(v.dtype), vw)
    return o.reshape(bsz, s_len, B_WIDTH)


def axial_rope_tables(s_len):
    rows = s_len // GRID_W
    row = jnp.repeat(jnp.arange(rows), GRID_W).astype(jnp.float32)
    col = jnp.tile(jnp.arange(GRID_W), rows).astype(jnp.float32)
    half = HEAD_DIM // 2
    freqs = ROPE_THETA ** (-jnp.arange(0, half, 2, dtype=jnp.float32) / half)
    ar = row[:, None] * freqs[None]
    ac = col[:, None] * freqs[None]
    return jnp.cos(ar), jnp.sin(ar), jnp.cos(ac), jnp.sin(ac)


def _rotate(x, cos, sin):
    x1, x2 = jnp.split(x, 2, axis=-1)
    c, s = cos[:, None, :], sin[:, None, :]
    return jnp.concatenate([x1 * c - x2 * s, x2 * c + x1 * s], axis=-1)


def apply_axial_rope(x, tabs):
    cr, sr, cc, scol = tabs
    xf = x.astype(jnp.float32)
    half = HEAD_DIM // 2
    y = jnp.concatenate([_rotate(xf[..., :half], cr, sr), _rotate(xf[..., half:], cc, scol)], axis=-1)
    return y.astype(x.dtype)


def grid_attention(q, k, v):
    bsz, s_len = q.shape[0], q.shape[1]
    nb = s_len // BLOCK
    grp = C_HEADS // C_KV
    scale = HEAD_DIM ** -0.5
    qb = q.reshape(bsz, nb, BLOCK, C_KV, grp, HEAD_DIM).transpose(1, 0, 2, 3, 4, 5)

    def block(qi):
        sc = jnp.einsum('bqkgd,bskd->bkgqs', qi, k).astype(jnp.float32) * scale
        p = jax.nn.softmax(sc, axis=-1)
        return jnp.einsum('bkgqs,bskd->bqkgd', p.astype(v.dtype), v)

    o = lax.map(block, qb)
    return o.transpose(1, 0, 2, 3, 4, 5).reshape(bsz, s_len, C_WIDTH)


def setup_inputs(seed: int = 0) -> dict:
    key = jax.random.key(seed)
    ks = jax.random.split(key, 20)
    f32 = jnp.float32

    def nrm(k, shape, scale):
        return jax.random.normal(k, shape, f32) * scale

    def gain(k, n):
        return 1.0 + 0.02 * jax.random.normal(k, (DEPTH, n), f32)

    return {
        "x": jax.random.normal(ks[0], (BATCH, SEQ, D_MODEL), f32),
        "w_in": nrm(ks[1], (DEPTH, D_MODEL, IN_WIDTH), D_MODEL ** -0.5),
        "w_out": nrm(ks[2], (DEPTH, MIX_WIDTH, D_MODEL), MIX_WIDTH ** -0.5),
        "g_pre_mix": gain(ks[3], D_MODEL),
        "g_post_mix": gain(ks[4], D_MODEL),
        "lam_q1": nrm(ks[5], (DEPTH, HEAD_DIM), 0.1),
        "lam_k1": nrm(ks[6], (DEPTH, HEAD_DIM), 0.1),
        "lam_q2": nrm(ks[7], (DEPTH, HEAD_DIM), 0.1),
        "lam_k2": nrm(ks[8], (DEPTH, HEAD_DIM), 0.1),
        "diff_subln_g": gain(ks[9], A_V),
        "sink_logits": nrm(ks[10], (DEPTH, B_HEADS), 0.5),
        "c_q_norm": gain(ks[11], HEAD_DIM),
        "c_k_norm": gain(ks[12], HEAD_DIM),
        "g_pre_mlp": gain(ks[13], D_MODEL),
        "g_post_mlp": gain(ks[14], D_MODEL),
        "w_mlp_in": nrm(ks[15], (DEPTH, D_MODEL, D_FF), D_MODEL ** -0.5),
        "w_mlp_out": nrm(ks[16], (DEPTH, D_FF, D_MODEL), D_FF ** -0.5),
    }


def reference(x, w_in, w_out, g_pre_mix, g_post_mix, lam_q1, lam_k1, lam_q2, lam_k2,
              diff_subln_g, sink_logits, c_q_norm, c_k_norm, g_pre_mlp, g_post_mlp,
              w_mlp_in, w_mlp_out):
    bsz, s_len = x.shape[0], x.shape[1]
    tabs = axial_rope_tables(s_len)
    pts = _split_points()
    for l in range(DEPTH):
        h = rms_norm(x, g_pre_mix[l])
        proj = h @ w_in[l]
        aq, ak, av, bq, bk, bv, cq, ck, cv = jnp.split(proj, pts, axis=-1)

        lam_init = 0.8 - 0.6 * math.exp(-0.3 * l)
        lam = (jnp.exp(jnp.sum(lam_q1[l].astype(jnp.float32) * lam_k1[l].astype(jnp.float32)))
               - jnp.exp(jnp.sum(lam_q2[l].astype(jnp.float32) * lam_k2[l].astype(jnp.float32)))
               + lam_init)
        a_out = diff_attention(aq.reshape(bsz, s_len, A_HEADS, 2, HEAD_DIM),
                               ak.reshape(bsz, s_len, A_HEADS, 2, HEAD_DIM),
                               av.reshape(bsz, s_len, A_HEADS, A_V),
                               lam, lam_init, diff_subln_g[l])

        b_out = window_attention(bq.reshape(bsz, s_len, B_HEADS, HEAD_DIM),
                                 bk.reshape(bsz, s_len, B_KV, HEAD_DIM),
                                 bv.reshape(bsz, s_len, B_KV, HEAD_DIM),
                                 sink_logits[l])

        cqh = apply_axial_rope(rms_norm(cq.reshape(bsz, s_len, C_HEADS, HEAD_DIM), c_q_norm[l]), tabs)
        ckh = apply_axial_rope(rms_norm(ck.reshape(bsz, s_len, C_KV, HEAD_DIM), c_k_norm[l]), tabs)
        c_out = grid_attention(cqh, ckh, cv.reshape(bsz, s_len, C_KV, HEAD_DIM))

        mix = jnp.concatenate([a_out, b_out, c_out], axis=-1) @ w_out[l]
        x = x + rms_norm(mix, g_post_mix[l])

        h = rms_norm(x, g_pre_mlp[l])
        y = jnp.square(jax.nn.relu(h @ w_mlp_in[l])) @ w_mlp_out[l]
        x = x + rms_norm(y, g_post_mlp[l])
    return x
```

```cpp
#include <hip/hip_runtime.h>
#include <hip/hip_cooperative_groups.h>
#include <cstdio>
#include <cstdint>
#include <cmath>
namespace pg8 {
#define PG8_LAS __attribute__((address_space(3)))
typedef unsigned short bf16_t;
typedef short bf16x8 __attribute__((ext_vector_type(8)));
typedef float f32x4 __attribute__((ext_vector_type(4)));
typedef unsigned u32x4 __attribute__((ext_vector_type(4)));
constexpr int BM = 256, BK = 64, HALF = 128, HTB = HALF * BK * 2  , STAGE_BYTES = 8 * HTB, NXCD = 8, WGM = 8;

__host__ __device__ __forceinline__ int lds_byte(int r, int c) { const int st = (r >> 4) * 2 + (c >> 5), rr = r & 15, cc = c & 31, ob = rr * 64 + cc * 2; return st * 1024 + (ob ^ (((ob >> 9) & 1) << 5)); }
__host__ __device__ __forceinline__ void stage_rc(int b, int& R, int& C) { const int st = b / 1024, sb = b % 1024, swz = sb ^ (((sb >> 9) & 1) << 5); R = (st >> 1) * 16 + swz / 64; C = (st & 1) * 32 + (swz % 64) / 2; }
__host__ __device__ __forceinline__ int perm32(int rho) { const int n = rho >> 4, i = rho & 15; return 8 * (i >> 2) + 4 * n + (i & 3); }

struct Unit { int pm, pn; };
struct Gemm { const bf16_t* A; const bf16_t* Bt; int M, N, K; };

struct StaticOrder {
    int nM, nN, nwg, G, c;
    __host__ __device__ void init(int M, int N, int G_, int c_) { nM = M / BM; nN = N / BM; nwg = nM * nN; G = G_; c = c_; }
    __host__ __device__ bool next(int i, Unit& u) const {
        const long L = (long)i * G + c; if (L >= nwg) return false;
        int wgid = (int)L; { const int q = nwg / NXCD, r = nwg % NXCD, xcd = wgid % NXCD, off = wgid / NXCD; wgid = (xcd < r ? xcd * (q + 1) : r * (q + 1) + (xcd - r) * q) + off; }
        const int nig = WGM * nN, gid = wgid / nig, fm = gid * WGM, gsz = (nM - fm) < WGM ? (nM - fm) : WGM;
        u.pm = fm + ((wgid % nig) % gsz); u.pn = (wgid % nig) / gsz; return true;
    }
    __device__ __forceinline__ void a_ready(const Unit&) const {}
    __device__ __forceinline__ void done(const Unit&) const {}
};

__device__ __forceinline__ unsigned cvt_pk_bf16(float lo, float hi) { unsigned r; asm volatile("v_cvt_pk_bf16_f32 %0, %1, %2" : "=v"(r) : "v"(lo), "v"(hi)); return r; }
template <int ACT  > struct EpiBf16 {
    static constexpr bool PERM = true, AFTER_DRAIN = false;
    bf16_t* O; int ldc; unsigned scale_mask; float scale;
    __device__ __forceinline__ void operator()(const f32x4 (&acc)[2][2][4][2], const Unit& u, int wr, int wc, int fr, int fq) const {
        const int row0 = u.pm * BM + wr * 64 + fr; const int col0 = u.pn * BM + wc * 32 + 8 * fq;
        const float sc = ((scale_mask >> u.pn) & 1u) ? scale : 1.f;
#pragma unroll
        for (int ai = 0; ai < 2; ++ai)
#pragma unroll
            for (int m = 0; m < 4; ++m) { bf16_t* rowp = O + (size_t)(row0 + ai * HALF + m * 16) * ldc + col0;
#pragma unroll
                for (int bj = 0; bj < 2; ++bj) { f32x4 v0 = acc[ai][bj][m][0], v1 = acc[ai][bj][m][1];
                    if (ACT == 1) {
#pragma unroll
                        for (int e = 0; e < 4; ++e) { const float a = fmaxf(v0[e], 0.f), b = fmaxf(v1[e], 0.f); v0[e] = a * a; v1[e] = b * b; } }
                    v0 = v0 * sc; v1 = v1 * sc; u32x4 w; w.x = cvt_pk_bf16(v0[0], v0[1]); w.y = cvt_pk_bf16(v0[2], v0[3]); w.z = cvt_pk_bf16(v1[0], v1[1]); w.w = cvt_pk_bf16(v1[2], v1[3]);
                    *(u32x4*)(rowp + bj * HALF) = w; } }
    }
};
struct EpiF32 {
    static constexpr bool PERM = false, AFTER_DRAIN = false;
    float* O; int ldc;
    __device__ __forceinline__ void operator()(const f32x4 (&acc)[2][2][4][2], const Unit& u, int wr, int wc, int fr, int fq) const {
        const int col0 = u.pn * BM + wc * 32 + 4 * fq;
#pragma unroll
        for (int ai = 0; ai < 2; ++ai)
#pragma unroll
            for (int m = 0; m < 4; ++m) { const size_t off = (size_t)(u.pm * BM + ai * HALF + wr * 64 + m * 16 + fr) * ldc + col0;
#pragma unroll
                for (int bj = 0; bj < 2; ++bj)
#pragma unroll
                    for (int n = 0; n < 2; ++n) *(f32x4*)(O + off + bj * HALF + n * 16) = acc[ai][bj][m][n]; }
    }
};
template <class Epi, class Sched, bool ALIGN_EPI = false, bool SP2 = false>
__device__ __forceinline__ void gemm_phase(PG8_LAS unsigned char* lds, const Gemm g, const Sched& S, const Epi& E) {
    int tid_ = threadIdx.x; asm volatile("" : "+v"(tid_));
    const int tid = tid_, wid = __builtin_amdgcn_readfirstlane(tid >> 6), lane = tid & 63, wr = wid >> 2, wc = wid & 3, fr = lane & 15, fq = lane >> 4;
    const int K = g.K, nt = K / BK;
    unsigned voffA[2], voffB[2];
#pragma unroll
    for (int i = 0; i < 2; ++i) { int R, C; stage_rc(tid * 16 + i * 8192, R, C); const int Rb = Epi::PERM ? ((R & ~31) + perm32(R & 31)) : R;
        voffA[i] = (unsigned)(R * K + C) * 2u; voffB[i] = (unsigned)(Rb * K + C) * 2u; }
    const size_t kstep = (size_t)(BK * 2);
    const size_t hstep = (size_t)HALF * K * 2;
    const size_t tstep = 2 * hstep;
    const unsigned ldsw = (unsigned)wid * 1024u;
    const int aoff = lds_byte(wr * 64 + fr, fq * 8), boff = lds_byte(wc * 32 + fr, fq * 8);
#define PG8_SA(b, h) (((b) * 2 + (h)) * HTB)
#define PG8_SB(b, h) ((4 + (b) * 2 + (h)) * HTB)
#define PG8_STAGE(bufoff, gbase, voff) do { _Pragma("unroll") for (int _i = 0; _i < 2; ++_i) \
        __builtin_amdgcn_global_load_lds((const unsigned*)((const char*)(gbase) + (voff)[_i]), (PG8_LAS unsigned*)(lds + (bufoff) + ldsw + _i * 8192), 16, 0, 0); } while (0)
#define PG8_LDA(dst, b, h) do { _Pragma("unroll") for (int m = 0; m < 4; ++m) _Pragma("unroll") for (int k = 0; k < 2; ++k) dst[m][k] = *(const PG8_LAS bf16x8*)(lds + PG8_SA(b, h) + aoff + m * 2048 + k * 1024); } while (0)
#define PG8_LDB(dst, b, h) do { _Pragma("unroll") for (int n = 0; n < 2; ++n) _Pragma("unroll") for (int k = 0; k < 2; ++k) dst[n][k] = *(const PG8_LAS bf16x8*)(lds + PG8_SB(b, h) + boff + n * 2048 + k * 1024); } while (0)
#define PG8_MMA(ai, bj, At, Bt) do { __builtin_amdgcn_s_setprio(1); _Pragma("unroll") for (int m = 0; m < 4; ++m) _Pragma("unroll") for (int n = 0; n < 2; ++n) _Pragma("unroll") for (int k = 0; k < 2; ++k) \
        acc[ai][bj][m][n] = __builtin_amdgcn_mfma_f32_16x16x32_bf16(Bt[n][k], At[m][k], acc[ai][bj][m][n], 0, 0, 0); __builtin_amdgcn_s_setprio(0); } while (0)
#define PG8_WAIT_V(n) asm volatile("s_waitcnt vmcnt(" #n ")" ::: "memory")
#define PG8_WAIT_L(n) asm volatile("s_waitcnt lgkmcnt(" #n ")" ::: "memory")
#define PG8_BAR __builtin_amdgcn_s_barrier()
#define PG8_SCHED __builtin_amdgcn_sched_barrier(0)
    Unit cur, nxt; int ui = 0;
    if (!S.next(0, cur)) return;
    f32x4 acc[2][2][4][2];
#pragma unroll
    for (int a = 0; a < 2; ++a)
#pragma unroll
        for (int b = 0; b < 2; ++b)
#pragma unroll
            for (int m = 0; m < 4; ++m)
#pragma unroll
                for (int n = 0; n < 2; ++n) acc[a][b][m][n] = (f32x4){0.f, 0.f, 0.f, 0.f};
    bf16x8 At[4][2], B0[2][2], B1[2][2];
    const char* cA = (const char*)g.A + (size_t)cur.pm * tstep; const char* cB = (const char*)g.Bt + (size_t)cur.pn * tstep;
    S.a_ready(cur);
    if constexpr (SP2) {
        PG8_STAGE(PG8_SB(0, 0), cB, voffB); PG8_STAGE(PG8_SB(0, 1), cB + hstep, voffB); PG8_STAGE(PG8_SA(0, 0), cA, voffA); PG8_STAGE(PG8_SA(0, 1), cA + hstep, voffA);
        if (wr == 1) PG8_BAR;
        PG8_WAIT_V(2); PG8_BAR;
        PG8_STAGE(PG8_SB(1, 0), cB + kstep, voffB); PG8_STAGE(PG8_SA(1, 0), cA + kstep, voffA); PG8_STAGE(PG8_SB(1, 1), cB + hstep + kstep, voffB);
        PG8_WAIT_V(6); PG8_BAR;
    } else {
        PG8_STAGE(PG8_SB(0, 0), cB, voffB); PG8_STAGE(PG8_SA(0, 0), cA, voffA); PG8_STAGE(PG8_SB(0, 1), cB + hstep, voffB); PG8_STAGE(PG8_SA(0, 1), cA + hstep, voffA);
        if (wr == 1) PG8_BAR;
        PG8_WAIT_V(4); PG8_BAR;
        PG8_STAGE(PG8_SB(1, 0), cB + kstep, voffB); PG8_STAGE(PG8_SA(1, 0), cA + kstep, voffA); PG8_STAGE(PG8_SB(1, 1), cB + hstep + kstep, voffB);
        PG8_WAIT_V(6); PG8_BAR;
    }
    for (;;) {
        const bool has_next = S.next(ui + 1, nxt);
        const char* nA = has_next ? (const char*)g.A + (size_t)nxt.pm * tstep : cA; const char* nB = has_next ? (const char*)g.Bt + (size_t)nxt.pn * tstep : cB;
        for (int t = 0; t < nt; t += 2) {
            const bool last = (t == nt - 2);
            const char* a1 = cA + (size_t)(t + 1) * kstep;
            const char* a2 = last ? nA : cA + (size_t)(t + 2) * kstep; const char* b2 = last ? nB : cB + (size_t)(t + 2) * kstep;
            const char* a3 = a2 + kstep; const char* b3 = b2 + kstep;
            if (last && has_next) S.a_ready(nxt);
            if constexpr (SP2) {
            PG8_LDB(B0, 0, 0); PG8_LDB(B1, 0, 1); PG8_SCHED; PG8_LDA(At, 0, 0); PG8_STAGE(PG8_SA(1, 1), a1 + hstep, voffA);
            PG8_WAIT_V(8); PG8_WAIT_L(0); PG8_BAR; PG8_MMA(0, 0, At, B0); PG8_MMA(0, 1, At, B1); PG8_BAR; PG8_SCHED;
            PG8_LDA(At, 0, 1); PG8_STAGE(PG8_SB(0, 0), b2, voffB); PG8_STAGE(PG8_SB(0, 1), b2 + hstep, voffB); PG8_STAGE(PG8_SA(0, 0), a2, voffA);
            PG8_WAIT_V(8); PG8_WAIT_L(0); PG8_BAR; PG8_MMA(1, 0, At, B0); PG8_MMA(1, 1, At, B1); PG8_BAR; PG8_SCHED;
            PG8_LDB(B0, 1, 0); PG8_LDB(B1, 1, 1); PG8_SCHED; PG8_LDA(At, 1, 0); PG8_STAGE(PG8_SA(0, 1), a2 + hstep, voffA);
            PG8_WAIT_V(8); PG8_WAIT_L(0); PG8_BAR; PG8_MMA(0, 0, At, B0); PG8_MMA(0, 1, At, B1); PG8_BAR; PG8_SCHED;
            PG8_LDA(At, 1, 1); PG8_STAGE(PG8_SB(1, 0), b3, voffB); PG8_STAGE(PG8_SB(1, 1), b3 + hstep, voffB); PG8_STAGE(PG8_SA(1, 0), a3, voffA);
            PG8_WAIT_V(8); PG8_WAIT_L(0); PG8_BAR; PG8_MMA(1, 0, At, B0); PG8_MMA(1, 1, At, B1); PG8_BAR; PG8_SCHED;
            } else {
            PG8_LDB(B0, 0, 0); PG8_SCHED; PG8_LDA(At, 0, 0); PG8_STAGE(PG8_SA(1, 1), a1 + hstep, voffA);
            PG8_WAIT_L(8); PG8_BAR; PG8_WAIT_L(0); PG8_MMA(0, 0, At, B0); PG8_BAR; PG8_SCHED;
            PG8_LDB(B1, 0, 1); PG8_STAGE(PG8_SB(0, 0), b2, voffB);
            PG8_BAR; PG8_WAIT_L(0); PG8_MMA(0, 1, At, B1); PG8_BAR;
            PG8_LDA(At, 0, 1); PG8_STAGE(PG8_SA(0, 0), a2, voffA);
            PG8_BAR; PG8_WAIT_L(0); PG8_MMA(1, 0, At, B0); PG8_BAR; PG8_SCHED;
            PG8_STAGE(PG8_SB(0, 1), b2 + hstep, voffB);
            PG8_WAIT_V(6); PG8_BAR; PG8_MMA(1, 1, At, B1); PG8_BAR;
            PG8_LDB(B0, 1, 0); PG8_SCHED; PG8_LDA(At, 1, 0); PG8_STAGE(PG8_SA(0, 1), a2 + hstep, voffA);
            PG8_WAIT_L(8); PG8_BAR; PG8_WAIT_L(0); PG8_MMA(0, 0, At, B0); PG8_BAR; PG8_SCHED;
            PG8_LDB(B1, 1, 1); PG8_STAGE(PG8_SB(1, 0), b3, voffB);
            PG8_BAR; PG8_WAIT_L(0); PG8_MMA(0, 1, At, B1); PG8_BAR;
            PG8_LDA(At, 1, 1); PG8_STAGE(PG8_SA(1, 0), a3, voffA);
            PG8_BAR; PG8_WAIT_L(0); PG8_MMA(1, 0, At, B0); PG8_BAR; PG8_SCHED;
            PG8_STAGE(PG8_SB(1, 1), b3 + hstep, voffB);
            PG8_WAIT_V(6); PG8_BAR; PG8_MMA(1, 1, At, B1); PG8_BAR;
            }
        }
        if constexpr (ALIGN_EPI) { if (wr == 0) PG8_BAR; }
        if constexpr (!Epi::AFTER_DRAIN) { E(acc, cur, wr, wc, fr, fq); S.done(cur); }
        if (!has_next) break;
#pragma unroll
        for (int a = 0; a < 2; ++a)
#pragma unroll
            for (int b = 0; b < 2; ++b)
#pragma unroll
                for (int m = 0; m < 4; ++m)
#pragma unroll
                    for (int n = 0; n < 2; ++n) acc[a][b][m][n] = (f32x4){0.f, 0.f, 0.f, 0.f};
        cur = nxt; cA = nA; cB = nB; ++ui;
        if constexpr (ALIGN_EPI) { if (wr == 1) PG8_BAR; }
    }
    PG8_WAIT_V(0);
    if constexpr (!ALIGN_EPI) { if (wr == 0) PG8_BAR; }
    PG8_BAR;
    if constexpr (Epi::AFTER_DRAIN) { E.fused(acc, cur, wr, wc, fr, fq, lds, wid, lane); S.done(cur); }
#undef PG8_SA
#undef PG8_SB
#undef PG8_STAGE
#undef PG8_LDA
#undef PG8_LDB
#undef PG8_MMA
#undef PG8_WAIT_V
#undef PG8_WAIT_L
#undef PG8_BAR
#undef PG8_SCHED
}
}
#ifndef PG8_SP2
#define PG8_SP2 true
#endif
#ifndef PG8_ALIGN
#define PG8_ALIGN true
#endif
namespace cg = cooperative_groups;

constexpr int NB = 8, S = 4096, M = NB * S, D = 1024, NIN = 2560, FF = 4096, DEPTH = 2;
constexpr int PITCH = NIN;
constexpr float EPS = 1e-6f;
constexpr float LOG2E = 1.4426950408889634f;
constexpr float C2 = 0.125f * LOG2E;
constexpr int C_AQ = 0, C_AK = 512, C_AV = 1024, C_BQ = 1536, C_BK = 1792, C_BV = 1920, C_CQ = 2048, C_CK = 2304, C_CV = 2432;
constexpr int MX_A = 0, MX_B = 512, MX_C = 768;

constexpr size_t MiB = 1u << 20;
constexpr size_t WS_CTL = 0, CTL_ZERO_BYTES = 1 * MiB;
constexpr size_t WS_TRIG = 1 * MiB;
constexpr size_t WS_WIN = 2 * MiB, WS_WOUT = 12 * MiB, WS_W1 = 16 * MiB, WS_W2 = 32 * MiB;
constexpr size_t WS_XN = 48 * MiB;
constexpr size_t WS_Y = 112 * MiB;
constexpr size_t WS_PROJ = 240 * MiB;
constexpr size_t WS_MIX = 400 * MiB;
constexpr size_t WS_H = 240 * MiB;
constexpr size_t WS_END = 496 * MiB;
static_assert(WS_H + (size_t)M * FF * 2 <= WS_END && WS_MIX + (size_t)M * D * 2 <= WS_END && WS_PROJ + (size_t)M * NIN * 2 <= WS_MIX && WS_Y + (size_t)M * D * 4 <= WS_PROJ && WS_XN + (size_t)M * D * 2 <= WS_Y, "ws map");

constexpr int NWAVES = 8;
constexpr int LDS_BYTES = 147456;
#define LAS __attribute__((address_space(3)))
typedef unsigned short bf16;
typedef float f32x4 __attribute__((ext_vector_type(4)));
typedef float f32x16 __attribute__((ext_vector_type(16)));
typedef short bf16x8 __attribute__((ext_vector_type(8)));
typedef unsigned v4u __attribute__((ext_vector_type(4)));

__device__ __forceinline__ unsigned f2bf(float f) { unsigned u = __builtin_bit_cast(unsigned, f); return (u + 0x7fffu + ((u >> 16) & 1u)) >> 16; }
__device__ __forceinline__ unsigned pk2(float lo, float hi) { return f2bf(lo) | (f2bf(hi) << 16); }
__device__ __forceinline__ float bf2f(unsigned short h) { return __builtin_bit_cast(float, (unsigned)h << 16); }
__device__ __forceinline__ float wave_sum(float v) {
#pragma unroll
    for (int o = 1; o < 64; o <<= 1) v += __shfl_xor(v, o);
    return v;
}
__device__ __forceinline__ int crow(int r, int hi) { return (r & 3) + 8 * (r >> 2) + 4 * hi; }

__device__ __forceinline__ void transpose_item(const float* W, int K, int N, bf16* WT, LAS float* scr, int item, int lane) {
    const int nblk = N / 32, kb = item / nblk, nb = item % nblk, k0 = 64 * kb, n0 = 32 * nb;
#pragma unroll 8
    for (int i = 0; i < 32; ++i) { const int kk = 2 * i + (lane >> 5); scr[kk * 33 + (lane & 31)] = W[(size_t)(k0 + kk) * N + n0 + (lane & 31)]; }
    asm volatile("s_waitcnt lgkmcnt(0)" ::: "memory");
    const int c = lane & 7;
#pragma unroll
    for (int j = 0; j < 4; ++j) { const int n = (lane >> 3) + 8 * j; const LAS float* s = scr + (8 * c) * 33 + n;
        v4u o; o.x = pk2(s[0 * 33], s[1 * 33]); o.y = pk2(s[2 * 33], s[3 * 33]); o.z = pk2(s[4 * 33], s[5 * 33]); o.w = pk2(s[6 * 33], s[7 * 33]);
        *(v4u*)(WT + (size_t)(n0 + n) * K + k0 + 8 * c) = o; }
    asm volatile("s_waitcnt lgkmcnt(0)" ::: "memory");
}
__device__ __forceinline__ void rms_row_to_bf16(const float* xrow, const float* g, bf16* orow, int lane) {
    const f32x4* xr = (const f32x4*)xrow + lane; const f32x4* gr = (const f32x4*)g + lane;
    f32x4 v[4]; float s = 0.f;
#pragma unroll
    for (int j = 0; j < 4; ++j) { v[j] = xr[64 * j]; s += (v[j].x * v[j].x + v[j].y * v[j].y) + (v[j].z * v[j].z + v[j].w * v[j].w); }
    const float rstd = 1.0f / sqrtf(wave_sum(s) * (1.f / D) + EPS);
    unsigned long long* o8 = (unsigned long long*)orow + lane;
#pragma unroll
    for (int j = 0; j < 4; ++j) { const f32x4 gg = gr[64 * j];
        o8[64 * j] = (unsigned long long)pk2(v[j].x * rstd * gg.x, v[j].y * rstd * gg.y) | ((unsigned long long)pk2(v[j].z * rstd * gg.z, v[j].w * rstd * gg.w) << 32); }
}
__device__ __forceinline__ void resnorm_row(const float* yrow, const float* baserow, float* outrow, const float* gpost, const float* gnext, bf16* xnrow, int lane) {
    const f32x4* yr = (const f32x4*)yrow + lane; const f32x4* br = (const f32x4*)baserow + lane; const f32x4* gp = (const f32x4*)gpost + lane;
    f32x4 v[4]; float s = 0.f;
#pragma unroll
    for (int j = 0; j < 4; ++j) { v[j] = yr[64 * j]; s += (v[j].x * v[j].x + v[j].y * v[j].y) + (v[j].z * v[j].z + v[j].w * v[j].w); }
    const float rstd = 1.0f / sqrtf(wave_sum(s) * (1.f / D) + EPS);
    float s2 = 0.f;
#pragma unroll
    for (int j = 0; j < 4; ++j) { const f32x4 b = br[64 * j], g = gp[64 * j]; v[j] = b + v[j] * rstd * g; s2 += (v[j].x * v[j].x + v[j].y * v[j].y) + (v[j].z * v[j].z + v[j].w * v[j].w); }
    f32x4* o = (f32x4*)outrow + lane;
#pragma unroll
    for (int j = 0; j < 4; ++j) o[64 * j] = v[j];
    if (gnext) {
        const float rstd2 = 1.0f / sqrtf(wave_sum(s2) * (1.f / D) + EPS);
        const f32x4* gn = (const f32x4*)gnext + lane; unsigned long long* o8 = (unsigned long long*)xnrow + lane;
#pragma unroll
        for (int j = 0; j < 4; ++j) { const f32x4 gg = gn[64 * j];
            o8[64 * j] = (unsigned long long)pk2(v[j].x * rstd2 * gg.x, v[j].y * rstd2 * gg.y) | ((unsigned long long)pk2(v[j].z * rstd2 * gg.z, v[j].w * rstd2 * gg.w) << 32); }
    }
}
__device__ __forceinline__ void cprep_row(bf16* prow, int pos, const float* gq, const float* gk, const float* trig, int lane) {
    const int idx = (lane < 32) ? (pos >> 6) : (pos & 63); const int fi = lane & 15;
    const float c = trig[idx * 16 + fi], sn = trig[1024 + idx * 16 + fi];
    const float gqv = gq[lane], gkv = gk[lane];
#pragma unroll
    for (int slot = 0; slot < 6; ++slot) {
        const int col = (slot < 4) ? (C_CQ + slot * 64) : (C_CK + (slot - 4) * 64);
        const float x = bf2f(prow[col + lane]);
        const float ss = wave_sum(x * x);
        const float xn = x * (1.0f / sqrtf(ss * (1.f / 64.f) + EPS)) * ((slot < 4) ? gqv : gkv);
        const float pr = __shfl_xor(xn, 16);
        float y = (lane & 16) ? (xn * c + pr * sn) : (xn * c - pr * sn);
        if (slot < 4) y *= C2;
        prow[col + lane] = (bf16)f2bf(y);
    }
}

template <int DV> __device__ __forceinline__ void attn_simple_unit(const bf16* __restrict__ P, int b, int qblk, int qcol, int kcol, int vcol, float slope2, bool window, float sink2,
                                                                   float* outf, bf16* outb, int opitch, int ocol, int lane) {
    const int r32 = lane & 31, hi = lane >> 5;
    const size_t rowbase = (size_t)b * S; const int q0 = qblk * 32; const int qpos = q0 + r32;
    bf16x8 qr[4];
#pragma unroll
    for (int d0 = 0; d0 < 4; ++d0) qr[d0] = *(const bf16x8*)(P + (rowbase + q0 + r32) * PITCH + qcol + d0 * 16 + hi * 8);
    int t_lo = 0, t_hi = S / 32;
    if (window) { int lo = q0 - 128; if (lo < 0) lo = 0; int hk = q0 + 32 + 128; if (hk > S) hk = S; t_lo = lo / 32; t_hi = hk / 32; }
    const float NEG = -INFINITY;
#define ATT_SCORES(p, t) do { p = f32x16{}; \
        _Pragma("unroll") for (int d0 = 0; d0 < 4; ++d0) { const bf16x8 kf = *(const bf16x8*)(P + (rowbase + (t) * 32 + r32) * PITCH + kcol + d0 * 16 + hi * 8); \
            p = __builtin_amdgcn_mfma_f32_32x32x16_bf16(kf, qr[d0], p, 0, 0, 0); } \
        _Pragma("unroll") for (int r = 0; r < 16; ++r) { const int kpos = (t) * 32 + crow(r, hi); int dist = qpos - kpos; dist = dist < 0 ? -dist : dist; \
            float v = p[r] - slope2 * (float)dist; if (window && dist > 128) v = NEG; p[r] = v; } } while (0)
    float m = NEG, l = 0.f;
    for (int t = t_lo; t < t_hi; ++t) {
        f32x16 p; ATT_SCORES(p, t);
        float tm = p[0];
#pragma unroll
        for (int r = 1; r < 16; ++r) tm = fmaxf(tm, p[r]);
        const float mn = fmaxf(m, tm); const float mref = (mn == NEG) ? 0.f : mn;
        float s = 0.f;
#pragma unroll
        for (int r = 0; r < 16; ++r) s += exp2f(p[r] - mref);
        l = l * exp2f(m - mref) + s; m = mn;
    }
    const float m2 = __shfl_xor(m, 32), l2 = __shfl_xor(l, 32);
    const float mn = fmaxf(fmaxf(m, m2), sink2);
    l = l * exp2f(m - mn) + l2 * exp2f(m2 - mn) + exp2f(sink2 - mn);
    const float rl = 1.0f / l;
    f32x16 o[DV / 32];
#pragma unroll
    for (int i = 0; i < DV / 32; ++i) o[i] = f32x16{};
    for (int t = t_lo; t < t_hi; ++t) {
        f32x16 p; ATT_SCORES(p, t);
#pragma unroll
        for (int r = 0; r < 16; ++r) p[r] = exp2f(p[r] - mn) * rl;
        bf16x8 pa[2];
#pragma unroll
        for (int s = 0; s < 2; ++s)
#pragma unroll
            for (int j = 0; j < 8; ++j) pa[s][j] = (short)f2bf(p[8 * s + j]);
#pragma unroll
        for (int db = 0; db < DV / 32; ++db)
#pragma unroll
            for (int s = 0; s < 2; ++s) { bf16x8 vf;
#pragma unroll
                for (int j = 0; j < 8; ++j) { const int key = t * 32 + 16 * s + 8 * (j >> 2) + 4 * hi + (j & 3); vf[j] = (short)P[(rowbase + key) * PITCH + vcol + db * 32 + r32]; }
                o[db] = __builtin_amdgcn_mfma_f32_32x32x16_bf16(pa[s], vf, o[db], 0, 0, 0); }
    }
#undef ATT_SCORES
#pragma unroll
    for (int db = 0; db < DV / 32; ++db)
#pragma unroll
        for (int r = 0; r < 16; ++r) { const size_t off = (rowbase + q0 + crow(r, hi)) * (size_t)opitch + ocol + db * 32 + r32;
            if (outf) outf[off] = o[db][r]; else outb[off] = (bf16)f2bf(o[db][r]); }
}

struct Args { const float* in[17]; float* out; unsigned char* ws; int ph_lo, ph_hi; };
enum { I_X = 0, I_WIN, I_WOUT, I_GPREMIX, I_GPOSTMIX, I_LQ1, I_LK1, I_LQ2, I_LK2, I_SUBLN, I_SINK, I_CQN, I_CKN, I_GPREMLP, I_GPOSTMLP, I_W1, I_W2 };
constexpr int PH_PER_LAYER = 9, N_PHASES = 1 + DEPTH * PH_PER_LAYER;

__global__ void __launch_bounds__(NWAVES * 64, 2) fwd(Args args) {
    extern __shared__ __attribute__((aligned(16))) unsigned char lds_raw[];
    LAS unsigned char* lds = (LAS unsigned char*)lds_raw;
    cg::grid_group grid = cg::this_grid();
    for (int ph = args.ph_lo; ph < args.ph_hi; ++ph) {
        int tid_ = threadIdx.x; asm volatile("" : "+v"(tid_));
        unsigned char* ws = args.ws; asm volatile("" : "+s"(ws));
        const int tid = tid_, lane = tid & 63, wave = __builtin_amdgcn_readfirstlane(tid >> 6);
        const int G = gridDim.x; const int bx = blockIdx.x; const int vcu = (G % 8 == 0) ? (bx % 8) * (G / 8) + bx / 8 : bx;
        const int gw = vcu * NWAVES + wave, NGW = G * NWAVES;
        const float* x = args.in[I_X]; float* out = args.out;
        float* trig = (float*)(ws + WS_TRIG);
        bf16* Win_t = (bf16*)(ws + WS_WIN); bf16* Wout_t = (bf16*)(ws + WS_WOUT); bf16* W1_t = (bf16*)(ws + WS_W1); bf16* W2_t = (bf16*)(ws + WS_W2);
        bf16* XN = (bf16*)(ws + WS_XN); float* Y = (float*)(ws + WS_Y); float* OA = (float*)(ws + WS_Y);
        bf16* PROJ = (bf16*)(ws + WS_PROJ); bf16* MIX = (bf16*)(ws + WS_MIX); bf16* HB = (bf16*)(ws + WS_H);
        if (ph == 0) {
            if (bx == 0) for (int i = tid; i < 1024; i += NWAVES * 64) { const int idx = i >> 4, k = i & 15;
                const float freq = exp2f(-(float)(2 * k) * (1.f / 32.f) * 13.287712379549449f);
                const float ang = (float)idx * freq; trig[i] = cosf(ang); trig[1024 + i] = sinf(ang); }
            LAS float* scr = (LAS float*)(lds + wave * 16384);
            constexpr int I_IN = (D / 64) * (NIN / 32), I_OUT = (D / 64) * (D / 32), I_1 = (D / 64) * (FF / 32), I_2 = (FF / 64) * (D / 32), I_LAYER = I_IN + I_OUT + I_1 + I_2;
            for (int it = gw; it < DEPTH * I_LAYER; it += NGW) {
                const int l = it / I_LAYER; int r = it % I_LAYER;
                if (r < I_IN) { transpose_item(args.in[I_WIN] + (size_t)l * D * NIN, D, NIN, Win_t + (size_t)l * NIN * D, scr, r, lane); continue; } r -= I_IN;
                if (r < I_OUT) { transpose_item(args.in[I_WOUT] + (size_t)l * D * D, D, D, Wout_t + (size_t)l * D * D, scr, r, lane); continue; } r -= I_OUT;
                if (r < I_1) { transpose_item(args.in[I_W1] + (size_t)l * D * FF, D, FF, W1_t + (size_t)l * FF * D, scr, r, lane); continue; } r -= I_1;
                transpose_item(args.in[I_W2] + (size_t)l * FF * D, FF, D, W2_t + (size_t)l * D * FF, scr, r, lane);
            }
            for (int m = gw; m < M; m += NGW) rms_row_to_bf16(x + (size_t)m * D, args.in[I_GPREMIX], XN + (size_t)m * D, lane);
            asm volatile("s_waitcnt vmcnt(0) lgkmcnt(0)" ::: "memory"); __syncthreads();
        } else {
            const int l = (ph - 1) / PH_PER_LAYER, sub = (ph - 1) % PH_PER_LAYER;
            switch (sub) {
            case 0: {
                pg8::Gemm g{XN, Win_t + (size_t)l * NIN * D, M, NIN, D}; pg8::StaticOrder So; So.init(M, NIN, G, bx);
                pg8::EpiBf16<0> E{PROJ, NIN, (1u << 0) | (1u << 1) | (1u << 6), C2};
                pg8::gemm_phase<pg8::EpiBf16<0>, pg8::StaticOrder, PG8_ALIGN, PG8_SP2>(lds, g, So, E);
            } break;
            case 1: {
                const float* gq = args.in[I_CQN] + l * 64; const float* gk = args.in[I_CKN] + l * 64;
                for (int m = gw; m < M; m += NGW) cprep_row(PROJ + (size_t)m * PITCH, m % S, gq, gk, trig, lane);
            } break;
            case 2: {
                constexpr int NQ = S / 32;
                constexpr int UA = NB * 4 * 2 * NQ, UB = NB * 4 * NQ, UC = NB * 4 * NQ;
                for (int u = gw; u < UA + UB + UC; u += NGW) {
                    if (u < UA) { const int qb = u % NQ, s = u / NQ, map = s & 1, h = (s >> 1) & 3, b = s >> 3;
                        attn_simple_unit<128>(PROJ, b, qb, C_AQ + h * 128 + map * 64, C_AK + h * 128 + map * 64, C_AV + h * 128, exp2f(-(float)(2 * h + 1)) * LOG2E, false, -INFINITY,
                                              OA + (size_t)map * M * 512, nullptr, 512, h * 128, lane);
                    } else if (u < UA + UB) { const int v = u - UA; const int qb = v % NQ, s = v / NQ, h = s & 3, b = s >> 2;
                        attn_simple_unit<64>(PROJ, b, qb, C_BQ + h * 64, C_BK + (h >> 1) * 64, C_BV + (h >> 1) * 64, exp2f(-(float)(2 * h + 2)) * LOG2E, true, args.in[I_SINK][l * 4 + h] * LOG2E,
                                             nullptr, MIX, D, MX_B + h * 64, lane);
                    } else { const int v = u - UA - UB; const int qb = v % NQ, s = v / NQ, h = s & 3, b = s >> 2;
                        attn_simple_unit<64>(PROJ, b, qb, C_CQ + h * 64, C_CK + (h >> 1) * 64, C_CV + (h >> 1) * 64, 0.f, false, -INFINITY,
                                             nullptr, MIX, D, MX_C + h * 64, lane);
                    }
                }
            } break;
            case 3: {
                const float lam_init = 0.8f - 0.6f * expf(-0.3f * (float)l);
                const float d1 = wave_sum(args.in[I_LQ1][l * 64 + lane] * args.in[I_LK1][l * 64 + lane]);
                const float d2 = wave_sum(args.in[I_LQ2][l * 64 + lane] * args.in[I_LK2][l * 64 + lane]);
                const float lam = expf(d1) - expf(d2) + lam_init;
                const float g0 = args.in[I_SUBLN][l * 128 + 2 * lane] * (1.f - lam_init), g1 = args.in[I_SUBLN][l * 128 + 2 * lane + 1] * (1.f - lam_init);
                for (int it = gw; it < M * 4; it += NGW) { const int m = it >> 2, h = it & 3; const size_t off = (size_t)m * 512 + h * 128 + 2 * lane;
                    const float2 a = *(const float2*)(OA + off), c = *(const float2*)(OA + (size_t)M * 512 + off);
                    const float o0 = a.x - lam * c.x, o1 = a.y - lam * c.y;
                    const float rstd = 1.0f / sqrtf(wave_sum(o0 * o0 + o1 * o1) * (1.f / 128.f) + EPS);
                    *(unsigned*)(MIX + (size_t)m * D + MX_A + h * 128 + 2 * lane) = pk2(o0 * rstd * g0, o1 * rstd * g1); }
            } break;
            case 4: {
                pg8::Gemm g{MIX, Wout_t + (size_t)l * D * D, M, D, D}; pg8::StaticOrder So; So.init(M, D, G, bx);
                pg8::EpiF32 E{Y, D};
                pg8::gemm_phase<pg8::EpiF32, pg8::StaticOrder, PG8_ALIGN, PG8_SP2>(lds, g, So, E);
            } break;
            case 5: {
                const float* base = (l == 0) ? x : out;
                for (int m = gw; m < M; m += NGW) resnorm_row(Y + (size_t)m * D, base + (size_t)m * D, out + (size_t)m * D, args.in[I_GPOSTMIX] + l * D, args.in[I_GPREMLP] + l * D, XN + (size_t)m * D, lane);
            } break;
            case 6: {
                pg8::Gemm g{XN, W1_t + (size_t)l * FF * D, M, FF, D}; pg8::StaticOrder So; So.init(M, FF, G, bx);
                pg8::EpiBf16<1> E{HB, FF, 0u, 1.f};
                pg8::gemm_phase<pg8::EpiBf16<1>, pg8::StaticOrder, PG8_ALIGN, PG8_SP2>(lds, g, So, E);
            } break;
            case 7: {
                pg8::Gemm g{HB, W2_t + (size_t)l * D * FF, M, D, FF}; pg8::StaticOrder So; So.init(M, D, G, bx);
                pg8::EpiF32 E{Y, D};
                pg8::gemm_phase<pg8::EpiF32, pg8::StaticOrder, PG8_ALIGN, PG8_SP2>(lds, g, So, E);
            } break;
            default: {
                const float* gnext = (l + 1 < DEPTH) ? args.in[I_GPREMIX] + (l + 1) * D : nullptr;
                for (int m = gw; m < M; m += NGW) resnorm_row(Y + (size_t)m * D, out + (size_t)m * D, out + (size_t)m * D, args.in[I_GPOSTMLP] + l * D, gnext, XN + (size_t)m * D, lane);
            } break;
            }
        }
        if (ph + 1 < args.ph_hi) grid.sync();
    }
}

#ifndef MK_ONE_LAUNCH
#define MK_ONE_LAUNCH 0
#endif
extern "C" void kernel_launch(void* const* d_in, const int* in_sizes, int n_in, void* d_out, int out_size, void* d_ws, size_t ws_size, hipStream_t stream) {
    static int grid = 0;
    if (grid == 0) {
        if (n_in != 17 || in_sizes[0] != M * D || out_size != M * D || ws_size < WS_END) { fprintf(stderr, "kernel_launch: unexpected shapes (n_in %d, in0 %d, out %d, ws %zu); nothing launched\n", n_in, n_in > 0 ? in_sizes[0] : -1, out_size, ws_size); grid = -1; return; }
        int dev = 0, cus = 0, per_cu = 0;
        if (hipGetDevice(&dev) != hipSuccess || hipDeviceGetAttribute(&cus, hipDeviceAttributeMultiprocessorCount, dev) != hipSuccess) { grid = -1; return; }
        if (hipFuncSetAttribute((const void*)fwd, hipFuncAttributeMaxDynamicSharedMemorySize, LDS_BYTES) != hipSuccess) { fprintf(stderr, "kernel_launch: hipFuncSetAttribute failed\n"); grid = -1; return; }
        if (hipOccupancyMaxActiveBlocksPerMultiprocessor(&per_cu, (const void*)fwd, NWAVES * 64, LDS_BYTES) != hipSuccess || per_cu < 1) { fprintf(stderr, "kernel_launch: occupancy query says %d blocks per CU\n", per_cu); per_cu = 1; }
        (void)hipGetLastError();
        grid = cus;
    }
    if (grid < 0) return;
    Args a{};
    for (int i = 0; i < 17; ++i) a.in[i] = (const float*)d_in[i];
    a.out = (float*)d_out; a.ws = (unsigned char*)d_ws;
#if MK_ONE_LAUNCH
    a.ph_lo = 0; a.ph_hi = N_PHASES;
    void* kargs[] = {&a};
    hipError_t e = hipLaunchCooperativeKernel((const void*)fwd, dim3(grid), dim3(NWAVES * 64), kargs, LDS_BYTES, stream);
    if (e != hipSuccess) fprintf(stderr, "kernel_launch: cooperative launch failed: %s (grid %d)\n", hipGetErrorString(e), grid);
#else
    for (int ph = 0; ph < N_PHASES; ++ph) { a.ph_lo = ph; a.ph_hi = ph + 1;
        hipLaunchKernelGGL(fwd, dim3(grid), dim3(NWAVES * 64), LDS_BYTES, stream, a);
        const hipError_t le = hipPeekAtLastError();
        if (le != hipSuccess) { fprintf(stderr, "kernel_launch: launch %d failed: %s\n", ph, hipGetErrorName(le)); break; } }
#endif
}
```

```cpp
#include <hip/hip_runtime.h>
#include <hip/hip_cooperative_groups.h>
#include <cstdio>
#include <cstdint>
#include <cmath>
namespace pg8 {
#define PG8_LAS __attribute__((address_space(3)))
typedef unsigned short bf16_t;
typedef short bf16x8 __attribute__((ext_vector_type(8)));
typedef float f32x4 __attribute__((ext_vector_type(4)));
typedef unsigned u32x4 __attribute__((ext_vector_type(4)));
constexpr int BM = 256, BK = 64, HALF = 128, HTB = HALF * BK * 2  , STAGE_BYTES = 8 * HTB, NXCD = 8, WGM = 8;

__host__ __device__ __forceinline__ int lds_byte(int r, int c) { const int st = (r >> 4) * 2 + (c >> 5), rr = r & 15, cc = c & 31, ob = rr * 64 + cc * 2; return st * 1024 + (ob ^ (((ob >> 9) & 1) << 5)); }
__host__ __device__ __forceinline__ void stage_rc(int b, int& R, int& C) { const int st = b / 1024, sb = b % 1024, swz = sb ^ (((sb >> 9) & 1) << 5); R = (st >> 1) * 16 + swz / 64; C = (st & 1) * 32 + (swz % 64) / 2; }
__host__ __device__ __forceinline__ int perm32(int rho) { const int n = rho >> 4, i = rho & 15; return 8 * (i >> 2) + 4 * n + (i & 3); }

struct Unit { int pm, pn; };
struct Gemm { const bf16_t* A; const bf16_t* Bt; int M, N, K; };

struct StaticOrder {
    int nM, nN, nwg, G, c;
    __host__ __device__ void init(int M, int N, int G_, int c_) { nM = M / BM; nN = N / BM; nwg = nM * nN; G = G_; c = c_; }
    __host__ __device__ bool next(int i, Unit& u) const {
        const long L = (long)i * G + c; if (L >= nwg) return false;
        int wgid = (int)L; { const int q = nwg / NXCD, r = nwg % NXCD, xcd = wgid % NXCD, off = wgid / NXCD; wgid = (xcd < r ? xcd * (q + 1) : r * (q + 1) + (xcd - r) * q) + off; }
        const int nig = WGM * nN, gid = wgid / nig, fm = gid * WGM, gsz = (nM - fm) < WGM ? (nM - fm) : WGM;
        u.pm = fm + ((wgid % nig) % gsz); u.pn = (wgid % nig) / gsz; return true;
    }
    __device__ __forceinline__ void a_ready(const Unit&) const {}
    __device__ __forceinline__ void done(const Unit&) const {}
};

__device__ __forceinline__ unsigned cvt_pk_bf16(float lo, float hi) { unsigned r; asm volatile("v_cvt_pk_bf16_f32 %0, %1, %2" : "=v"(r) : "v"(lo), "v"(hi)); return r; }
template <int ACT  > struct EpiBf16 {
    static constexpr bool PERM = true, AFTER_DRAIN = false;
    bf16_t* O; int ldc; unsigned scale_mask; float scale;
    __device__ __forceinline__ void operator()(const f32x4 (&acc)[2][2][4][2], const Unit& u, int wr, int wc, int fr, int fq) const {
        const int row0 = u.pm * BM + wr * 64 + fr; const int col0 = u.pn * BM + wc * 32 + 8 * fq;
        const float sc = ((scale_mask >> u.pn) & 1u) ? scale : 1.f;
#pragma unroll
        for (int ai = 0; ai < 2; ++ai)
#pragma unroll
            for (int m = 0; m < 4; ++m) { bf16_t* rowp = O + (size_t)(row0 + ai * HALF + m * 16) * ldc + col0;
#pragma unroll
                for (int bj = 0; bj < 2; ++bj) { f32x4 v0 = acc[ai][bj][m][0], v1 = acc[ai][bj][m][1];
                    if (ACT == 1) {
#pragma unroll
                        for (int e = 0; e < 4; ++e) { const float a = fmaxf(v0[e], 0.f), b = fmaxf(v1[e], 0.f); v0[e] = a * a; v1[e] = b * b; } }
                    v0 = v0 * sc; v1 = v1 * sc; u32x4 w; w.x = cvt_pk_bf16(v0[0], v0[1]); w.y = cvt_pk_bf16(v0[2], v0[3]); w.z = cvt_pk_bf16(v1[0], v1[1]); w.w = cvt_pk_bf16(v1[2], v1[3]);
                    *(u32x4*)(rowp + bj * HALF) = w; } }
    }
};
struct EpiF32 {
    static constexpr bool PERM = false, AFTER_DRAIN = false;
    float* O; int ldc;
    __device__ __forceinline__ void operator()(const f32x4 (&acc)[2][2][4][2], const Unit& u, int wr, int wc, int fr, int fq) const {
        const int col0 = u.pn * BM + wc * 32 + 4 * fq;
#pragma unroll
        for (int ai = 0; ai < 2; ++ai)
#pragma unroll
            for (int m = 0; m < 4; ++m) { const size_t off = (size_t)(u.pm * BM + ai * HALF + wr * 64 + m * 16 + fr) * ldc + col0;
#pragma unroll
                for (int bj = 0; bj < 2; ++bj)
#pragma unroll
                    for (int n = 0; n < 2; ++n) *(f32x4*)(O + off + bj * HALF + n * 16) = acc[ai][bj][m][n]; }
    }
};
template <class Epi, class Sched, bool ALIGN_EPI = false, bool SP2 = false>
__device__ __forceinline__ void gemm_phase(PG8_LAS unsigned char* lds, const Gemm g, const Sched& S, const Epi& E) {
    int tid_ = threadIdx.x; asm volatile("" : "+v"(tid_));
    const int tid = tid_, wid = __builtin_amdgcn_readfirstlane(tid >> 6), lane = tid & 63, wr = wid >> 2, wc = wid & 3, fr = lane & 15, fq = lane >> 4;
    const int K = g.K, nt = K / BK;
    unsigned voffA[2], voffB[2];
#pragma unroll
    for (int i = 0; i < 2; ++i) { int R, C; stage_rc(tid * 16 + i * 8192, R, C); const int Rb = Epi::PERM ? ((R & ~31) + perm32(R & 31)) : R;
        voffA[i] = (unsigned)(R * K + C) * 2u; voffB[i] = (unsigned)(Rb * K + C) * 2u; }
    const size_t kstep = (size_t)(BK * 2);
    const size_t hstep = (size_t)HALF * K * 2;
    const size_t tstep = 2 * hstep;
    const unsigned ldsw = (unsigned)wid * 1024u;
    const int aoff = lds_byte(wr * 64 + fr, fq * 8), boff = lds_byte(wc * 32 + fr, fq * 8);
#define PG8_SA(b, h) (((b) * 2 + (h)) * HTB)
#define PG8_SB(b, h) ((4 + (b) * 2 + (h)) * HTB)
#define PG8_STAGE(bufoff, gbase, voff) do { _Pragma("unroll") for (int _i = 0; _i < 2; ++_i) \
        __builtin_amdgcn_global_load_lds((const unsigned*)((const char*)(gbase) + (voff)[_i]), (PG8_LAS unsigned*)(lds + (bufoff) + ldsw + _i * 8192), 16, 0, 0); } while (0)
#define PG8_LDA(dst, b, h) do { _Pragma("unroll") for (int m = 0; m < 4; ++m) _Pragma("unroll") for (int k = 0; k < 2; ++k) dst[m][k] = *(const PG8_LAS bf16x8*)(lds + PG8_SA(b, h) + aoff + m * 2048 + k * 1024); } while (0)
#define PG8_LDB(dst, b, h) do { _Pragma("unroll") for (int n = 0; n < 2; ++n) _Pragma("unroll") for (int k = 0; k < 2; ++k) dst[n][k] = *(const PG8_LAS bf16x8*)(lds + PG8_SB(b, h) + boff + n * 2048 + k * 1024); } while (0)
#define PG8_MMA(ai, bj, At, Bt) do { __builtin_amdgcn_s_setprio(1); _Pragma("unroll") for (int m = 0; m < 4; ++m) _Pragma("unroll") for (int n = 0; n < 2; ++n) _Pragma("unroll") for (int k = 0; k < 2; ++k) \
        acc[ai][bj][m][n] = __builtin_amdgcn_mfma_f32_16x16x32_bf16(Bt[n][k], At[m][k], acc[ai][bj][m][n], 0, 0, 0); __builtin_amdgcn_s_setprio(0); } while (0)
#define PG8_WAIT_V(n) asm volatile("s_waitcnt vmcnt(" #n ")" ::: "memory")
#define PG8_WAIT_L(n) asm volatile("s_waitcnt lgkmcnt(" #n ")" ::: "memory")
#define PG8_BAR __builtin_amdgcn_s_barrier()
#define PG8_SCHED __builtin_amdgcn_sched_barrier(0)
    Unit cur, nxt; int ui = 0;
    if (!S.next(0, cur)) return;
    f32x4 acc[2][2][4][2];
#pragma unroll
    for (int a = 0; a < 2; ++a)
#pragma unroll
        for (int b = 0; b < 2; ++b)
#pragma unroll
            for (int m = 0; m < 4; ++m)
#pragma unroll
                for (int n = 0; n < 2; ++n) acc[a][b][m][n] = (f32x4){0.f, 0.f, 0.f, 0.f};
    bf16x8 At[4][2], B0[2][2], B1[2][2];
    const char* cA = (const char*)g.A + (size_t)cur.pm * tstep; const char* cB = (const char*)g.Bt + (size_t)cur.pn * tstep;
    S.a_ready(cur);
    if constexpr (SP2) {
        PG8_STAGE(PG8_SB(0, 0), cB, voffB); PG8_STAGE(PG8_SB(0, 1), cB + hstep, voffB); PG8_STAGE(PG8_SA(0, 0), cA, voffA); PG8_STAGE(PG8_SA(0, 1), cA + hstep, voffA);
        if (wr == 1) PG8_BAR;
        PG8_WAIT_V(2); PG8_BAR;
        PG8_STAGE(PG8_SB(1, 0), cB + kstep, voffB); PG8_STAGE(PG8_SA(1, 0), cA + kstep, voffA); PG8_STAGE(PG8_SB(1, 1), cB + hstep + kstep, voffB);
        PG8_WAIT_V(6); PG8_BAR;
    } else {
        PG8_STAGE(PG8_SB(0, 0), cB, voffB); PG8_STAGE(PG8_SA(0, 0), cA, voffA); PG8_STAGE(PG8_SB(0, 1), cB + hstep, voffB); PG8_STAGE(PG8_SA(0, 1), cA + hstep, voffA);
        if (wr == 1) PG8_BAR;
        PG8_WAIT_V(4); PG8_BAR;
        PG8_STAGE(PG8_SB(1, 0), cB + kstep, voffB); PG8_STAGE(PG8_SA(1, 0), cA + kstep, voffA); PG8_STAGE(PG8_SB(1, 1), cB + hstep + kstep, voffB);
        PG8_WAIT_V(6); PG8_BAR;
    }
    for (;;) {
        const bool has_next = S.next(ui + 1, nxt);
        const char* nA = has_next ? (const char*)g.A + (size_t)nxt.pm * tstep : cA; const char* nB = has_next ? (const char*)g.Bt + (size_t)nxt.pn * tstep : cB;
        for (int t = 0; t < nt; t += 2) {
            const bool last = (t == nt - 2);
            const char* a1 = cA + (size_t)(t + 1) * kstep;
            const char* a2 = last ? nA : cA + (size_t)(t + 2) * kstep; const char* b2 = last ? nB : cB + (size_t)(t + 2) * kstep;
            const char* a3 = a2 + kstep; const char* b3 = b2 + kstep;
            if (last && has_next) S.a_ready(nxt);
            if constexpr (SP2) {
            PG8_LDB(B0, 0, 0); PG8_LDB(B1, 0, 1); PG8_SCHED; PG8_LDA(At, 0, 0); PG8_STAGE(PG8_SA(1, 1), a1 + hstep, voffA);
            PG8_WAIT_V(8); PG8_WAIT_L(0); PG8_BAR; PG8_MMA(0, 0, At, B0); PG8_MMA(0, 1, At, B1); PG8_BAR; PG8_SCHED;
            PG8_LDA(At, 0, 1); PG8_STAGE(PG8_SB(0, 0), b2, voffB); PG8_STAGE(PG8_SB(0, 1), b2 + hstep, voffB); PG8_STAGE(PG8_SA(0, 0), a2, voffA);
            PG8_WAIT_V(8); PG8_WAIT_L(0); PG8_BAR; PG8_MMA(1, 0, At, B0); PG8_MMA(1, 1, At, B1); PG8_BAR; PG8_SCHED;
            PG8_LDB(B0, 1, 0); PG8_LDB(B1, 1, 1); PG8_SCHED; PG8_LDA(At, 1, 0); PG8_STAGE(PG8_SA(0, 1), a2 + hstep, voffA);
            PG8_WAIT_V(8); PG8_WAIT_L(0); PG8_BAR; PG8_MMA(0, 0, At, B0); PG8_MMA(0, 1, At, B1); PG8_BAR; PG8_SCHED;
            PG8_LDA(At, 1, 1); PG8_STAGE(PG8_SB(1, 0), b3, voffB); PG8_STAGE(PG8_SB(1, 1), b3 + hstep, voffB); PG8_STAGE(PG8_SA(1, 0), a3, voffA);
            PG8_WAIT_V(8); PG8_WAIT_L(0); PG8_BAR; PG8_MMA(1, 0, At, B0); PG8_MMA(1, 1, At, B1); PG8_BAR; PG8_SCHED;
            } else {
            PG8_LDB(B0, 0, 0); PG8_SCHED; PG8_LDA(At, 0, 0); PG8_STAGE(PG8_SA(1, 1), a1 + hstep, voffA);
            PG8_WAIT_L(8); PG8_BAR; PG8_WAIT_L(0); PG8_MMA(0, 0, At, B0); PG8_BAR; PG8_SCHED;
            PG8_LDB(B1, 0, 1); PG8_STAGE(PG8_SB(0, 0), b2, voffB);
            PG8_BAR; PG8_WAIT_L(0); PG8_MMA(0, 1, At, B1); PG8_BAR;
            PG8_LDA(At, 0, 1); PG8_STAGE(PG8_SA(0, 0), a2, voffA);
            PG8_BAR; PG8_WAIT_L(0); PG8_MMA(1, 0, At, B0); PG8_BAR; PG8_SCHED;
            PG8_STAGE(PG8_SB(0, 1), b2 + hstep, voffB);
            PG8_WAIT_V(6); PG8_BAR; PG8_MMA(1, 1, At, B1); PG8_BAR;
            PG8_LDB(B0, 1, 0); PG8_SCHED; PG8_LDA(At, 1, 0); PG8_STAGE(PG8_SA(0, 1), a2 + hstep, voffA);
            PG8_WAIT_L(8); PG8_BAR; PG8_WAIT_L(0); PG8_MMA(0, 0, At, B0); PG8_BAR; PG8_SCHED;
            PG8_LDB(B1, 1, 1); PG8_STAGE(PG8_SB(1, 0), b3, voffB);
            PG8_BAR; PG8_WAIT_L(0); PG8_MMA(0, 1, At, B1); PG8_BAR;
            PG8_LDA(At, 1, 1); PG8_STAGE(PG8_SA(1, 0), a3, voffA);
            PG8_BAR; PG8_WAIT_L(0); PG8_MMA(1, 0, At, B0); PG8_BAR; PG8_SCHED;
            PG8_STAGE(PG8_SB(1, 1), b3 + hstep, voffB);
            PG8_WAIT_V(6); PG8_BAR; PG8_MMA(1, 1, At, B1); PG8_BAR;
            }
        }
        if constexpr (ALIGN_EPI) { if (wr == 0) PG8_BAR; }
        if constexpr (!Epi::AFTER_DRAIN) { E(acc, cur, wr, wc, fr, fq); S.done(cur); }
        if (!has_next) break;
#pragma unroll
        for (int a = 0; a < 2; ++a)
#pragma unroll
            for (int b = 0; b < 2; ++b)
#pragma unroll
                for (int m = 0; m < 4; ++m)
#pragma unroll
                    for (int n = 0; n < 2; ++n) acc[a][b][m][n] = (f32x4){0.f, 0.f, 0.f, 0.f};
        cur = nxt; cA = nA; cB = nB; ++ui;
        if constexpr (ALIGN_EPI) { if (wr == 1) PG8_BAR; }
    }
    PG8_WAIT_V(0);
    if constexpr (!ALIGN_EPI) { if (wr == 0) PG8_BAR; }
    PG8_BAR;
    if constexpr (Epi::AFTER_DRAIN) { E.fused(acc, cur, wr, wc, fr, fq, lds, wid, lane); S.done(cur); }
#undef PG8_SA
#undef PG8_SB
#undef PG8_STAGE
#undef PG8_LDA
#undef PG8_LDB
#undef PG8_MMA
#undef PG8_WAIT_V
#undef PG8_WAIT_L
#undef PG8_BAR
#undef PG8_SCHED
}
}
#ifndef PG8_SP2
#define PG8_SP2 true
#endif
#ifndef PG8_ALIGN
#define PG8_ALIGN true
#endif
namespace cg = cooperative_groups;

constexpr int NB = 8, S = 4096, M = NB * S, D = 1024, NIN = 2560, FF = 4096, DEPTH = 2;
constexpr int PITCH = NIN;
constexpr float EPS = 1e-6f;
constexpr float LOG2E = 1.4426950408889634f;
constexpr float C2 = 0.125f * LOG2E;
constexpr int C_AQ = 0, C_AK = 512, C_AV = 1024, C_BQ = 1536, C_BK = 1792, C_BV = 1920, C_CQ = 2048, C_CK = 2304, C_CV = 2432;
constexpr int MX_A = 0, MX_B = 512, MX_C = 768;

constexpr size_t MiB = 1u << 20;
constexpr size_t WS_CTL = 0, CTL_ZERO_BYTES = 1 * MiB;
constexpr size_t WS_TRIG = 1 * MiB;
constexpr size_t WS_WIN = 2 * MiB, WS_WOUT = 12 * MiB, WS_W1 = 16 * MiB, WS_W2 = 32 * MiB;
constexpr size_t WS_XN = 48 * MiB;
constexpr size_t WS_Y = 112 * MiB;
constexpr size_t WS_PROJ = 240 * MiB;
constexpr size_t WS_MIX = 400 * MiB;
constexpr size_t WS_H = 240 * MiB;
constexpr size_t WS_END = 496 * MiB;
static_assert(WS_H + (size_t)M * FF * 2 <= WS_END && WS_MIX + (size_t)M * D * 2 <= WS_END && WS_PROJ + (size_t)M * NIN * 2 <= WS_MIX && WS_Y + (size_t)M * D * 4 <= WS_PROJ && WS_XN + (size_t)M * D * 2 <= WS_Y, "ws map");

constexpr int NWAVES = 8;
constexpr int LDS_BYTES = 147456;
#define LAS __attribute__((address_space(3)))
typedef unsigned short bf16;
typedef float f32x4 __attribute__((ext_vector_type(4)));
typedef float f32x16 __attribute__((ext_vector_type(16)));
typedef short bf16x8 __attribute__((ext_vector_type(8)));
typedef unsigned v4u __attribute__((ext_vector_type(4)));

__device__ __forceinline__ unsigned f2bf(float f) { unsigned u = __builtin_bit_cast(unsigned, f); return (u + 0x7fffu + ((u >> 16) & 1u)) >> 16; }
__device__ __forceinline__ unsigned pk2(float lo, float hi) { return f2bf(lo) | (f2bf(hi) << 16); }
__device__ __forceinline__ float bf2f(unsigned short h) { return __builtin_bit_cast(float, (unsigned)h << 16); }
__device__ __forceinline__ float wave_sum(float v) {
#pragma unroll
    for (int o = 1; o < 64; o <<= 1) v += __shfl_xor(v, o);
    return v;
}
__device__ __forceinline__ int crow(int r, int hi) { return (r & 3) + 8 * (r >> 2) + 4 * hi; }

__device__ __forceinline__ void transpose_item(const float* W, int K, int N, bf16* WT, LAS float* scr, int item, int lane) {
    const int nblk = N / 32, kb = item / nblk, nb = item % nblk, k0 = 64 * kb, n0 = 32 * nb;
#pragma unroll 8
    for (int i = 0; i < 32; ++i) { const int kk = 2 * i + (lane >> 5); scr[kk * 33 + (lane & 31)] = W[(size_t)(k0 + kk) * N + n0 + (lane & 31)]; }
    asm volatile("s_waitcnt lgkmcnt(0)" ::: "memory");
    const int c = lane & 7;
#pragma unroll
    for (int j = 0; j < 4; ++j) { const int n = (lane >> 3) + 8 * j; const LAS float* s = scr + (8 * c) * 33 + n;
        v4u o; o.x = pk2(s[0 * 33], s[1 * 33]); o.y = pk2(s[2 * 33], s[3 * 33]); o.z = pk2(s[4 * 33], s[5 * 33]); o.w = pk2(s[6 * 33], s[7 * 33]);
        *(v4u*)(WT + (size_t)(n0 + n) * K + k0 + 8 * c) = o; }
    asm volatile("s_waitcnt lgkmcnt(0)" ::: "memory");
}
__device__ __forceinline__ void rms_row_to_bf16(const float* xrow, const float* g, bf16* orow, int lane) {
    const f32x4* xr = (const f32x4*)xrow + lane; const f32x4* gr = (const f32x4*)g + lane;
    f32x4 v[4]; float s = 0.f;
#pragma unroll
    for (int j = 0; j < 4; ++j) { v[j] = xr[64 * j]; s += (v[j].x * v[j].x + v[j].y * v[j].y) + (v[j].z * v[j].z + v[j].w * v[j].w); }
    const float rstd = 1.0f / sqrtf(wave_sum(s) * (1.f / D) + EPS);
    unsigned long long* o8 = (unsigned long long*)orow + lane;
#pragma unroll
    for (int j = 0; j < 4; ++j) { const f32x4 gg = gr[64 * j];
        o8[64 * j] = (unsigned long long)pk2(v[j].x * rstd * gg.x, v[j].y * rstd * gg.y) | ((unsigned long long)pk2(v[j].z * rstd * gg.z, v[j].w * rstd * gg.w) << 32); }
}
__device__ __forceinline__ void resnorm_row(const float* yrow, const float* baserow, float* outrow, const float* gpost, const float* gnext, bf16* xnrow, int lane) {
    const f32x4* yr = (const f32x4*)yrow + lane; const f32x4* br = (const f32x4*)baserow + lane; const f32x4* gp = (const f32x4*)gpost + lane;
    f32x4 v[4]; float s = 0.f;
#pragma unroll
    for (int j = 0; j < 4; ++j) { v[j] = yr[64 * j]; s += (v[j].x * v[j].x + v[j].y * v[j].y) + (v[j].z * v[j].z + v[j].w * v[j].w); }
    const float rstd = 1.0f / sqrtf(wave_sum(s) * (1.f / D) + EPS);
    float s2 = 0.f;
#pragma unroll
    for (int j = 0; j < 4; ++j) { const f32x4 b = br[64 * j], g = gp[64 * j]; v[j] = b + v[j] * rstd * g; s2 += (v[j].x * v[j].x + v[j].y * v[j].y) + (v[j].z * v[j].z + v[j].w * v[j].w); }
    f32x4* o = (f32x4*)outrow + lane;
#pragma unroll
    for (int j = 0; j < 4; ++j) o[64 * j] = v[j];
    if (gnext) {
        const float rstd2 = 1.0f / sqrtf(wave_sum(s2) * (1.f / D) + EPS);
        const f32x4* gn = (const f32x4*)gnext + lane; unsigned long long* o8 = (unsigned long long*)xnrow + lane;
#pragma unroll
        for (int j = 0; j < 4; ++j) { const f32x4 gg = gn[64 * j];
            o8[64 * j] = (unsigned long long)pk2(v[j].x * rstd2 * gg.x, v[j].y * rstd2 * gg.y) | ((unsigned long long)pk2(v[j].z * rstd2 * gg.z, v[j].w * rstd2 * gg.w) << 32); }
    }
}
__device__ __forceinline__ void cprep_row(bf16* prow, int pos, const float* gq, const float* gk, const float* trig, int lane) {
    const int idx = (lane < 32) ? (pos >> 6) : (pos & 63); const int fi = lane & 15;
    const float c = trig[idx * 16 + fi], sn = trig[1024 + idx * 16 + fi];
    const float gqv = gq[lane], gkv = gk[lane];
#pragma unroll
    for (int slot = 0; slot < 6; ++slot) {
        const int col = (slot < 4) ? (C_CQ + slot * 64) : (C_CK + (slot - 4) * 64);
        const float x = bf2f(prow[col + lane]);
        const float ss = wave_sum(x * x);
        const float xn = x * (1.0f / sqrtf(ss * (1.f / 64.f) + EPS)) * ((slot < 4) ? gqv : gkv);
        const float pr = __shfl_xor(xn, 16);
        float y = (lane & 16) ? (xn * c + pr * sn) : (xn * c - pr * sn);
        if (slot < 4) y *= C2;
        prow[col + lane] = (bf16)f2bf(y);
    }
}

template <int DV> __device__ __forceinline__ void attn_simple_unit(const bf16* __restrict__ P, int b, int qblk, int qcol, int kcol, int vcol, float slope2, bool window, float sink2,
                                                                   float* outf, bf16* outb, int opitch, int ocol, int lane) {
    const int r32 = lane & 31, hi = lane >> 5;
    const size_t rowbase = (size_t)b * S; const int q0 = qblk * 32; const int qpos = q0 + r32;
    bf16x8 qr[4];
#pragma unroll
    for (int d0 = 0; d0 < 4; ++d0) qr[d0] = *(const bf16x8*)(P + (rowbase + q0 + r32) * PITCH + qcol + d0 * 16 + hi * 8);
    int t_lo = 0, t_hi = S / 32;
    if (window) { int lo = q0 - 128; if (lo < 0) lo = 0; int hk = q0 + 32 + 128; if (hk > S) hk = S; t_lo = lo / 32; t_hi = hk / 32; }
    const float NEG = -INFINITY;
#define ATT_SCORES(p, t) do { p = f32x16{}; \
        _Pragma("unroll") for (int d0 = 0; d0 < 4; ++d0) { const bf16x8 kf = *(const bf16x8*)(P + (rowbase + (t) * 32 + r32) * PITCH + kcol + d0 * 16 + hi * 8); \
            p = __builtin_amdgcn_mfma_f32_32x32x16_bf16(kf, qr[d0], p, 0, 0, 0); } \
        _Pragma("unroll") for (int r = 0; r < 16; ++r) { const int kpos = (t) * 32 + crow(r, hi); int dist = qpos - kpos; dist = dist < 0 ? -dist : dist; \
            float v = p[r] - slope2 * (float)dist; if (window && dist > 128) v = NEG; p[r] = v; } } while (0)
    float m = NEG, l = 0.f;
    for (int t = t_lo; t < t_hi; ++t) {
        f32x16 p; ATT_SCORES(p, t);
        float tm = p[0];
#pragma unroll
        for (int r = 1; r < 16; ++r) tm = fmaxf(tm, p[r]);
        const float mn = fmaxf(m, tm); const float mref = (mn == NEG) ? 0.f : mn;
        float s = 0.f;
#pragma unroll
        for (int r = 0; r < 16; ++r) s += exp2f(p[r] - mref);
        l = l * exp2f(m - mref) + s; m = mn;
    }
    const float m2 = __shfl_xor(m, 32), l2 = __shfl_xor(l, 32);
    const float mn = fmaxf(fmaxf(m, m2), sink2);
    l = l * exp2f(m - mn) + l2 * exp2f(m2 - mn) + exp2f(sink2 - mn);
    const float rl = 1.0f / l;
    f32x16 o[DV / 32];
#pragma unroll
    for (int i = 0; i < DV / 32; ++i) o[i] = f32x16{};
    for (int t = t_lo; t < t_hi; ++t) {
        f32x16 p; ATT_SCORES(p, t);
#pragma unroll
        for (int r = 0; r < 16; ++r) p[r] = exp2f(p[r] - mn) * rl;
        bf16x8 pa[2];
#pragma unroll
        for (int s = 0; s < 2; ++s)
#pragma unroll
            for (int j = 0; j < 8; ++j) pa[s][j] = (short)f2bf(p[8 * s + j]);
#pragma unroll
        for (int db = 0; db < DV / 32; ++db)
#pragma unroll
            for (int s = 0; s < 2; ++s) { bf16x8 vf;
#pragma unroll
                for (int j = 0; j < 8; ++j) { const int key = t * 32 + 16 * s + 8 * (j >> 2) + 4 * hi + (j & 3); vf[j] = (short)P[(rowbase + key) * PITCH + vcol + db * 32 + r32]; }
                o[db] = __builtin_amdgcn_mfma_f32_32x32x16_bf16(pa[s], vf, o[db], 0, 0, 0); }
    }
#undef ATT_SCORES
#pragma unroll
    for (int db = 0; db < DV / 32; ++db)
#pragma unroll
        for (int r = 0; r < 16; ++r) { const size_t off = (rowbase + q0 + crow(r, hi)) * (size_t)opitch + ocol + db * 32 + r32;
            if (outf) outf[off] = o[db][r]; else outb[off] = (bf16)f2bf(o[db][r]); }
}

struct Args { const float* in[17]; float* out; unsigned char* ws; int ph_lo, ph_hi; };
enum { I_X = 0, I_WIN, I_WOUT, I_GPREMIX, I_GPOSTMIX, I_LQ1, I_LK1, I_LQ2, I_LK2, I_SUBLN, I_SINK, I_CQN, I_CKN, I_GPREMLP, I_GPOSTMLP, I_W1, I_W2 };
constexpr int PH_PER_LAYER = 9, N_PHASES = 1 + DEPTH * PH_PER_LAYER;

__global__ void __launch_bounds__(NWAVES * 64, 2) fwd(Args args) {
    extern __shared__ __attribute__((aligned(16))) unsigned char lds_raw[];
    LAS unsigned char* lds = (LAS unsigned char*)lds_raw;
    cg::grid_group grid = cg::this_grid();
    for (int ph = args.ph_lo; ph < args.ph_hi; ++ph) {
        int tid_ = threadIdx.x; asm volatile("" : "+v"(tid_));
        unsigned char* ws = args.ws; asm volatile("" : "+s"(ws));
        const int tid = tid_, lane = tid & 63, wave = __builtin_amdgcn_readfirstlane(tid >> 6);
        const int G = gridDim.x; const int bx = blockIdx.x; const int vcu = (G % 8 == 0) ? (bx % 8) * (G / 8) + bx / 8 : bx;
        const int gw = vcu * NWAVES + wave, NGW = G * NWAVES;
        const float* x = args.in[I_X]; float* out = args.out;
        float* trig = (float*)(ws + WS_TRIG);
        bf16* Win_t = (bf16*)(ws + WS_WIN); bf16* Wout_t = (bf16*)(ws + WS_WOUT); bf16* W1_t = (bf16*)(ws + WS_W1); bf16* W2_t = (bf16*)(ws + WS_W2);
        bf16* XN = (bf16*)(ws + WS_XN); float* Y = (float*)(ws + WS_Y); float* OA = (float*)(ws + WS_Y);
        bf16* PROJ = (bf16*)(ws + WS_PROJ); bf16* MIX = (bf16*)(ws + WS_MIX); bf16* HB = (bf16*)(ws + WS_H);
        if (ph == 0) {
            if (bx == 0) for (int i = tid; i < 1024; i += NWAVES * 64) { const int idx = i >> 4, k = i & 15;
                const float freq = exp2f(-(float)(2 * k) * (1.f / 32.f) * 13.287712379549449f);
                const float ang = (float)idx * freq; trig[i] = cosf(ang); trig[1024 + i] = sinf(ang); }
            LAS float* scr = (LAS float*)(lds + wave * 16384);
            constexpr int I_IN = (D / 64) * (NIN / 32), I_OUT = (D / 64) * (D / 32), I_1 = (D / 64) * (FF / 32), I_2 = (FF / 64) * (D / 32), I_LAYER = I_IN + I_OUT + I_1 + I_2;
            for (int it = gw; it < DEPTH * I_LAYER; it += NGW) {
                const int l = it / I_LAYER; int r = it % I_LAYER;
                if (r < I_IN) { transpose_item(args.in[I_WIN] + (size_t)l * D * NIN, D, NIN, Win_t + (size_t)l * NIN * D, scr, r, lane); continue; } r -= I_IN;
                if (r < I_OUT) { transpose_item(args.in[I_WOUT] + (size_t)l * D * D, D, D, Wout_t + (size_t)l * D * D, scr, r, lane); continue; } r -= I_OUT;
                if (r < I_1) { transpose_item(args.in[I_W1] + (size_t)l * D * FF, D, FF, W1_t + (size_t)l * FF * D, scr, r, lane); continue; } r -= I_1;
                transpose_item(args.in[I_W2] + (size_t)l * FF * D, FF, D, W2_t + (size_t)l * D * FF, scr, r, lane);
            }
            for (int m = gw; m < M; m += NGW) rms_row_to_bf16(x + (size_t)m * D, args.in[I_GPREMIX], XN + (size_t)m * D, lane);
            asm volatile("s_waitcnt vmcnt(0) lgkmcnt(0)" ::: "memory"); __syncthreads();
        } else {
            const int l = (ph - 1) / PH_PER_LAYER, sub = (ph - 1) % PH_PER_LAYER;
            switch (sub) {
            case 0: {
                pg8::Gemm g{XN, Win_t + (size_t)l * NIN * D, M, NIN, D}; pg8::StaticOrder So; So.init(M, NIN, G, bx);
                pg8::EpiBf16<0> E{PROJ, NIN, (1u << 0) | (1u << 1) | (1u << 6), C2};
                pg8::gemm_phase<pg8::EpiBf16<0>, pg8::StaticOrder, PG8_ALIGN, PG8_SP2>(lds, g, So, E);
            } break;
            case 1: {
                const float* gq = args.in[I_CQN] + l * 64; const float* gk = args.in[I_CKN] + l * 64;
                for (int m = gw; m < M; m += NGW) cprep_row(PROJ + (size_t)m * PITCH, m % S, gq, gk, trig, lane);
            } break;
            case 2: {
                constexpr int NQ = S / 32;
                constexpr int UA = NB * 4 * 2 * NQ, UB = NB * 4 * NQ, UC = NB * 4 * NQ;
                for (int u = gw; u < UA + UB + UC; u += NGW) {
                    if (u < UA) { const int qb = u % NQ, s = u / NQ, map = s & 1, h = (s >> 1) & 3, b = s >> 3;
                        attn_simple_unit<128>(PROJ, b, qb, C_AQ + h * 128 + map * 64, C_AK + h * 128 + map * 64, C_AV + h * 128, exp2f(-(float)(2 * h + 1)) * LOG2E, false, -INFINITY,
                                              OA + (size_t)map * M * 512, nullptr, 512, h * 128, lane);
                    } else if (u < UA + UB) { const int v = u - UA; const int qb = v % NQ, s = v / NQ, h = s & 3, b = s >> 2;
                        attn_simple_unit<64>(PROJ, b, qb, C_BQ + h * 64, C_BK + (h >> 1) * 64, C_BV + (h >> 1) * 64, exp2f(-(float)(2 * h + 2)) * LOG2E, true, args.in[I_SINK][l * 4 + h] * LOG2E,
                                             nullptr, MIX, D, MX_B + h * 64, lane);
                    } else { const int v = u - UA - UB; const int qb = v % NQ, s = v / NQ, h = s & 3, b = s >> 2;
                        attn_simple_unit<64>(PROJ, b, qb, C_CQ + h * 64, C_CK + (h >> 1) * 64, C_CV + (h >> 1) * 64, 0.f, false, -INFINITY,
                                             nullptr, MIX, D, MX_C + h * 64, lane);
                    }
                }
            } break;
            case 3: {
                const float lam_init = 0.8f - 0.6f * expf(-0.3f * (float)l);
                const float d1 = wave_sum(args.in[I_LQ1][l * 64 + lane] * args.in[I_LK1][l * 64 + lane]);
                const float d2 = wave_sum(args.in[I_LQ2][l * 64 + lane] * args.in[I_LK2][l * 64 + lane]);
                const float lam = expf(d1) - expf(d2) + lam_init;
                const float g0 = args.in[I_SUBLN][l * 128 + 2 * lane] * (1.f - lam_init), g1 = args.in[I_SUBLN][l * 128 + 2 * lane + 1] * (1.f - lam_init);
                for (int it = gw; it < M * 4; it += NGW) { const int m = it >> 2, h = it & 3; const size_t off = (size_t)m * 512 + h * 128 + 2 * lane;
                    const float2 a = *(const float2*)(OA + off), c = *(const float2*)(OA + (size_t)M * 512 + off);
                    const float o0 = a.x - lam * c.x, o1 = a.y - lam * c.y;
                    const float rstd = 1.0f / sqrtf(wave_sum(o0 * o0 + o1 * o1) * (1.f / 128.f) + EPS);
                    *(unsigned*)(MIX + (size_t)m * D + MX_A + h * 128 + 2 * lane) = pk2(o0 * rstd * g0, o1 * rstd * g1); }
            } break;
            case 4: {
                pg8::Gemm g{MIX, Wout_t + (size_t)l * D * D, M, D, D}; pg8::StaticOrder So; So.init(M, D, G, bx);
                pg8::EpiF32 E{Y, D};
                pg8::gemm_phase<pg8::EpiF32, pg8::StaticOrder, PG8_ALIGN, PG8_SP2>(lds, g, So, E);
            } break;
            case 5: {
                const float* base = (l == 0) ? x : out;
                for (int m = gw; m < M; m += NGW) resnorm_row(Y + (size_t)m * D, base + (size_t)m * D, out + (size_t)m * D, args.in[I_GPOSTMIX] + l * D, args.in[I_GPREMLP] + l * D, XN + (size_t)m * D, lane);
            } break;
            case 6: {
                pg8::Gemm g{XN, W1_t + (size_t)l * FF * D, M, FF, D}; pg8::StaticOrder So; So.init(M, FF, G, bx);
                pg8::EpiBf16<1> E{HB, FF, 0u, 1.f};
                pg8::gemm_phase<pg8::EpiBf16<1>, pg8::StaticOrder, PG8_ALIGN, PG8_SP2>(lds, g, So, E);
            } break;
            case 7: {
                pg8::Gemm g{HB, W2_t + (size_t)l * D * FF, M, D, FF}; pg8::StaticOrder So; So.init(M, D, G, bx);
                pg8::EpiF32 E{Y, D};
                pg8::gemm_phase<pg8::EpiF32, pg8::StaticOrder, PG8_ALIGN, PG8_SP2>(lds, g, So, E);
            } break;
            default: {
                const float* gnext = (l + 1 < DEPTH) ? args.in[I_GPREMIX] + (l + 1) * D : nullptr;
                for (int m = gw; m < M; m += NGW) resnorm_row(Y + (size_t)m * D, out + (size_t)m * D, out + (size_t)m * D, args.in[I_GPOSTMLP] + l * D, gnext, XN + (size_t)m * D, lane);
            } break;
            }
        }
        if (ph + 1 < args.ph_hi) grid.sync();
    }
}

#ifndef MK_ONE_LAUNCH
#define MK_ONE_LAUNCH 1
#endif
extern "C" void kernel_launch(void* const* d_in, const int* in_sizes, int n_in, void* d_out, int out_size, void* d_ws, size_t ws_size, hipStream_t stream) {
    static int grid = 0;
    if (grid == 0) {
        if (n_in != 17 || in_sizes[0] != M * D || out_size != M * D || ws_size < WS_END) { fprintf(stderr, "kernel_launch: unexpected shapes (n_in %d, in0 %d, out %d, ws %zu); nothing launched\n", n_in, n_in > 0 ? in_sizes[0] : -1, out_size, ws_size); grid = -1; return; }
        int dev = 0, cus = 0, per_cu = 0;
        if (hipGetDevice(&dev) != hipSuccess || hipDeviceGetAttribute(&cus, hipDeviceAttributeMultiprocessorCount, dev) != hipSuccess) { grid = -1; return; }
        if (hipFuncSetAttribute((const void*)fwd, hipFuncAttributeMaxDynamicSharedMemorySize, LDS_BYTES) != hipSuccess) { fprintf(stderr, "kernel_launch: hipFuncSetAttribute failed\n"); grid = -1; return; }
        if (hipOccupancyMaxActiveBlocksPerMultiprocessor(&per_cu, (const void*)fwd, NWAVES * 64, LDS_BYTES) != hipSuccess || per_cu < 1) { fprintf(stderr, "kernel_launch: occupancy query says %d blocks per CU\n", per_cu); per_cu = 1; }
        (void)hipGetLastError();
        grid = cus;
    }
    if (grid < 0) return;
    Args a{};
    for (int i = 0; i < 17; ++i) a.in[i] = (const float*)d_in[i];
    a.out = (float*)d_out; a.ws = (unsigned char*)d_ws;
#if MK_ONE_LAUNCH
    a.ph_lo = 0; a.ph_hi = N_PHASES;
    void* kargs[] = {&a};
    hipError_t e = hipLaunchCooperativeKernel((const void*)fwd, dim3(grid), dim3(NWAVES * 64), kargs, LDS_BYTES, stream);
    if (e != hipSuccess) fprintf(stderr, "kernel_launch: cooperative launch failed: %s (grid %d)\n", hipGetErrorString(e), grid);
#else
    for (int ph = 0; ph < N_PHASES; ++ph) { a.ph_lo = ph; a.ph_hi = ph + 1;
        hipLaunchKernelGGL(fwd, dim3(grid), dim3(NWAVES * 64), LDS_BYTES, stream, a);
        const hipError_t le = hipPeekAtLastError();
        if (le != hipSuccess) { fprintf(stderr, "kernel_launch: launch %d failed: %s\n", ph, hipGetErrorName(le)); break; } }
#endif
}
```

```cpp
#include <hip/hip_runtime.h>
#include <hip/hip_cooperative_groups.h>
#include <hip/hip_bf16.h>
#include <cstdio>
#include <cstdint>
#include <cmath>
namespace pg8 {
#define PG8_LAS __attribute__((address_space(3)))
typedef unsigned short bf16_t;
typedef short bf16x8 __attribute__((ext_vector_type(8)));
typedef float f32x4 __attribute__((ext_vector_type(4)));
typedef unsigned u32x4 __attribute__((ext_vector_type(4)));
constexpr int BM = 256, BK = 64, HALF = 128, HTB = HALF * BK * 2  , STAGE_BYTES = 8 * HTB, NXCD = 8, WGM = 8;

__host__ __device__ __forceinline__ int lds_byte(int r, int c) { const int st = (r >> 4) * 2 + (c >> 5), rr = r & 15, cc = c & 31, ob = rr * 64 + cc * 2; return st * 1024 + (ob ^ (((ob >> 9) & 1) << 5)); }
__host__ __device__ __forceinline__ void stage_rc(int b, int& R, int& C) { const int st = b / 1024, sb = b % 1024, swz = sb ^ (((sb >> 9) & 1) << 5); R = (st >> 1) * 16 + swz / 64; C = (st & 1) * 32 + (swz % 64) / 2; }
__host__ __device__ __forceinline__ int perm32(int rho) { const int n = rho >> 4, i = rho & 15; return 8 * (i >> 2) + 4 * n + (i & 3); }

struct Unit { int pm, pn; };
struct Gemm { const bf16_t* A; const bf16_t* Bt; int M, N, K; };

struct StaticOrder {
    int nM, nN, nwg, G, c;
    __host__ __device__ void init(int M, int N, int G_, int c_) { nM = M / BM; nN = N / BM; nwg = nM * nN; G = G_; c = c_; }
    __host__ __device__ bool next(int i, Unit& u) const {
        const long L = (long)i * G + c; if (L >= nwg) return false;
        int wgid = (int)L; { const int q = nwg / NXCD, r = nwg % NXCD, xcd = wgid % NXCD, off = wgid / NXCD; wgid = (xcd < r ? xcd * (q + 1) : r * (q + 1) + (xcd - r) * q) + off; }
        const int nig = WGM * nN, gid = wgid / nig, fm = gid * WGM, gsz = (nM - fm) < WGM ? (nM - fm) : WGM;
        u.pm = fm + ((wgid % nig) % gsz); u.pn = (wgid % nig) / gsz; return true;
    }
    __device__ __forceinline__ void a_ready(const Unit&) const {}
    __device__ __forceinline__ void done(const Unit&) const {}
};

__device__ __forceinline__ unsigned cvt_pk_bf16(float lo, float hi) { unsigned r; asm volatile("v_cvt_pk_bf16_f32 %0, %1, %2" : "=v"(r) : "v"(lo), "v"(hi)); return r; }
template <int ACT  > struct EpiBf16 {
    static constexpr bool PERM = true, AFTER_DRAIN = false;
    bf16_t* O; int ldc; unsigned scale_mask; float scale;
    __device__ __forceinline__ void operator()(const f32x4 (&acc)[2][2][4][2], const Unit& u, int wr, int wc, int fr, int fq) const {
        const int row0 = u.pm * BM + wr * 64 + fr; const int col0 = u.pn * BM + wc * 32 + 8 * fq;
        const float sc = ((scale_mask >> u.pn) & 1u) ? scale : 1.f;
#pragma unroll
        for (int ai = 0; ai < 2; ++ai)
#pragma unroll
            for (int m = 0; m < 4; ++m) { bf16_t* rowp = O + (size_t)(row0 + ai * HALF + m * 16) * ldc + col0;
#pragma unroll
                for (int bj = 0; bj < 2; ++bj) { f32x4 v0 = acc[ai][bj][m][0], v1 = acc[ai][bj][m][1];
                    if (ACT == 1) {
#pragma unroll
                        for (int e = 0; e < 4; ++e) { const float a = fmaxf(v0[e], 0.f), b = fmaxf(v1[e], 0.f); v0[e] = a * a; v1[e] = b * b; } }
                    v0 = v0 * sc; v1 = v1 * sc; u32x4 w; w.x = cvt_pk_bf16(v0[0], v0[1]); w.y = cvt_pk_bf16(v0[2], v0[3]); w.z = cvt_pk_bf16(v1[0], v1[1]); w.w = cvt_pk_bf16(v1[2], v1[3]);
                    *(u32x4*)(rowp + bj * HALF) = w; } }
    }
};
struct EpiF32 {
    static constexpr bool PERM = false, AFTER_DRAIN = false;
    float* O; int ldc;
    __device__ __forceinline__ void operator()(const f32x4 (&acc)[2][2][4][2], const Unit& u, int wr, int wc, int fr, int fq) const {
        const int col0 = u.pn * BM + wc * 32 + 4 * fq;
#pragma unroll
        for (int ai = 0; ai < 2; ++ai)
#pragma unroll
            for (int m = 0; m < 4; ++m) { const size_t off = (size_t)(u.pm * BM + ai * HALF + wr * 64 + m * 16 + fr) * ldc + col0;
#pragma unroll
                for (int bj = 0; bj < 2; ++bj)
#pragma unroll
                    for (int n = 0; n < 2; ++n) *(f32x4*)(O + off + bj * HALF + n * 16) = acc[ai][bj][m][n]; }
    }
};
template <class Epi, class Sched, bool ALIGN_EPI = false, bool SP2 = false>
__device__ __forceinline__ void gemm_phase(PG8_LAS unsigned char* lds, const Gemm g, const Sched& S, const Epi& E) {
    int tid_ = threadIdx.x; asm volatile("" : "+v"(tid_));
    const int tid = tid_, wid = __builtin_amdgcn_readfirstlane(tid >> 6), lane = tid & 63, wr = wid >> 2, wc = wid & 3, fr = lane & 15, fq = lane >> 4;
    const int K = g.K, nt = K / BK;
    unsigned voffA[2], voffB[2];
#pragma unroll
    for (int i = 0; i < 2; ++i) { int R, C; stage_rc(tid * 16 + i * 8192, R, C); const int Rb = Epi::PERM ? ((R & ~31) + perm32(R & 31)) : R;
        voffA[i] = (unsigned)(R * K + C) * 2u; voffB[i] = (unsigned)(Rb * K + C) * 2u; }
    const size_t kstep = (size_t)(BK * 2);
    const size_t hstep = (size_t)HALF * K * 2;
    const size_t tstep = 2 * hstep;
    const unsigned ldsw = (unsigned)wid * 1024u;
    const int aoff = lds_byte(wr * 64 + fr, fq * 8), boff = lds_byte(wc * 32 + fr, fq * 8);
#define PG8_SA(b, h) (((b) * 2 + (h)) * HTB)
#define PG8_SB(b, h) ((4 + (b) * 2 + (h)) * HTB)
#define PG8_STAGE(bufoff, gbase, voff) do { _Pragma("unroll") for (int _i = 0; _i < 2; ++_i) \
        __builtin_amdgcn_global_load_lds((const unsigned*)((const char*)(gbase) + (voff)[_i]), (PG8_LAS unsigned*)(lds + (bufoff) + ldsw + _i * 8192), 16, 0, 0); } while (0)
#define PG8_LDA(dst, b, h) do { _Pragma("unroll") for (int m = 0; m < 4; ++m) _Pragma("unroll") for (int k = 0; k < 2; ++k) dst[m][k] = *(const PG8_LAS bf16x8*)(lds + PG8_SA(b, h) + aoff + m * 2048 + k * 1024); } while (0)
#define PG8_LDB(dst, b, h) do { _Pragma("unroll") for (int n = 0; n < 2; ++n) _Pragma("unroll") for (int k = 0; k < 2; ++k) dst[n][k] = *(const PG8_LAS bf16x8*)(lds + PG8_SB(b, h) + boff + n * 2048 + k * 1024); } while (0)
#define PG8_MMA(ai, bj, At, Bt) do { __builtin_amdgcn_s_setprio(1); _Pragma("unroll") for (int m = 0; m < 4; ++m) _Pragma("unroll") for (int n = 0; n < 2; ++n) _Pragma("unroll") for (int k = 0; k < 2; ++k) \
        acc[ai][bj][m][n] = __builtin_amdgcn_mfma_f32_16x16x32_bf16(Bt[n][k], At[m][k], acc[ai][bj][m][n], 0, 0, 0); __builtin_amdgcn_s_setprio(0); } while (0)
#define PG8_WAIT_V(n) asm volatile("s_waitcnt vmcnt(" #n ")" ::: "memory")
#define PG8_WAIT_L(n) asm volatile("s_waitcnt lgkmcnt(" #n ")" ::: "memory")
#define PG8_BAR __builtin_amdgcn_s_barrier()
#define PG8_SCHED __builtin_amdgcn_sched_barrier(0)
    Unit cur, nxt; int ui = 0;
    if (!S.next(0, cur)) return;
    f32x4 acc[2][2][4][2];
#pragma unroll
    for (int a = 0; a < 2; ++a)
#pragma unroll
        for (int b = 0; b < 2; ++b)
#pragma unroll
            for (int m = 0; m < 4; ++m)
#pragma unroll
                for (int n = 0; n < 2; ++n) acc[a][b][m][n] = (f32x4){0.f, 0.f, 0.f, 0.f};
    bf16x8 At[4][2], B0[2][2], B1[2][2];
    const char* cA = (const char*)g.A + (size_t)cur.pm * tstep; const char* cB = (const char*)g.Bt + (size_t)cur.pn * tstep;
    S.a_ready(cur);
    if constexpr (SP2) {
        PG8_STAGE(PG8_SB(0, 0), cB, voffB); PG8_STAGE(PG8_SB(0, 1), cB + hstep, voffB); PG8_STAGE(PG8_SA(0, 0), cA, voffA); PG8_STAGE(PG8_SA(0, 1), cA + hstep, voffA);
        if (wr == 1) PG8_BAR;
        PG8_WAIT_V(2); PG8_BAR;
        PG8_STAGE(PG8_SB(1, 0), cB + kstep, voffB); PG8_STAGE(PG8_SA(1, 0), cA + kstep, voffA); PG8_STAGE(PG8_SB(1, 1), cB + hstep + kstep, voffB);
        PG8_WAIT_V(6); PG8_BAR;
    } else {
        PG8_STAGE(PG8_SB(0, 0), cB, voffB); PG8_STAGE(PG8_SA(0, 0), cA, voffA); PG8_STAGE(PG8_SB(0, 1), cB + hstep, voffB); PG8_STAGE(PG8_SA(0, 1), cA + hstep, voffA);
        if (wr == 1) PG8_BAR;
        PG8_WAIT_V(4); PG8_BAR;
        PG8_STAGE(PG8_SB(1, 0), cB + kstep, voffB); PG8_STAGE(PG8_SA(1, 0), cA + kstep, voffA); PG8_STAGE(PG8_SB(1, 1), cB + hstep + kstep, voffB);
        PG8_WAIT_V(6); PG8_BAR;
    }
    for (;;) {
        const bool has_next = S.next(ui + 1, nxt);
        const char* nA = has_next ? (const char*)g.A + (size_t)nxt.pm * tstep : cA; const char* nB = has_next ? (const char*)g.Bt + (size_t)nxt.pn * tstep : cB;
        for (int t = 0; t < nt; t += 2) {
            const bool last = (t == nt - 2);
            const char* a1 = cA + (size_t)(t + 1) * kstep;
            const char* a2 = last ? nA : cA + (size_t)(t + 2) * kstep; const char* b2 = last ? nB : cB + (size_t)(t + 2) * kstep;
            const char* a3 = a2 + kstep; const char* b3 = b2 + kstep;
            if (last && has_next) S.a_ready(nxt);
            if constexpr (SP2) {
            PG8_LDB(B0, 0, 0); PG8_LDB(B1, 0, 1); PG8_SCHED; PG8_LDA(At, 0, 0); PG8_STAGE(PG8_SA(1, 1), a1 + hstep, voffA);
            PG8_WAIT_V(8); PG8_WAIT_L(0); PG8_BAR; PG8_MMA(0, 0, At, B0); PG8_MMA(0, 1, At, B1); PG8_BAR; PG8_SCHED;
            PG8_LDA(At, 0, 1); PG8_STAGE(PG8_SB(0, 0), b2, voffB); PG8_STAGE(PG8_SB(0, 1), b2 + hstep, voffB); PG8_STAGE(PG8_SA(0, 0), a2, voffA);
            PG8_WAIT_V(8); PG8_WAIT_L(0); PG8_BAR; PG8_MMA(1, 0, At, B0); PG8_MMA(1, 1, At, B1); PG8_BAR; PG8_SCHED;
            PG8_LDB(B0, 1, 0); PG8_LDB(B1, 1, 1); PG8_SCHED; PG8_LDA(At, 1, 0); PG8_STAGE(PG8_SA(0, 1), a2 + hstep, voffA);
            PG8_WAIT_V(8); PG8_WAIT_L(0); PG8_BAR; PG8_MMA(0, 0, At, B0); PG8_MMA(0, 1, At, B1); PG8_BAR; PG8_SCHED;
            PG8_LDA(At, 1, 1); PG8_STAGE(PG8_SB(1, 0), b3, voffB); PG8_STAGE(PG8_SB(1, 1), b3 + hstep, voffB); PG8_STAGE(PG8_SA(1, 0), a3, voffA);
            PG8_WAIT_V(8); PG8_WAIT_L(0); PG8_BAR; PG8_MMA(1, 0, At, B0); PG8_MMA(1, 1, At, B1); PG8_BAR; PG8_SCHED;
            } else {
            PG8_LDB(B0, 0, 0); PG8_SCHED; PG8_LDA(At, 0, 0); PG8_STAGE(PG8_SA(1, 1), a1 + hstep, voffA);
            PG8_WAIT_L(8); PG8_BAR; PG8_WAIT_L(0); PG8_MMA(0, 0, At, B0); PG8_BAR; PG8_SCHED;
            PG8_LDB(B1, 0, 1); PG8_STAGE(PG8_SB(0, 0), b2, voffB);
            PG8_BAR; PG8_WAIT_L(0); PG8_MMA(0, 1, At, B1); PG8_BAR;
            PG8_LDA(At, 0, 1); PG8_STAGE(PG8_SA(0, 0), a2, voffA);
            PG8_BAR; PG8_WAIT_L(0); PG8_MMA(1, 0, At, B0); PG8_BAR; PG8_SCHED;
            PG8_STAGE(PG8_SB(0, 1), b2 + hstep, voffB);
            PG8_WAIT_V(6); PG8_BAR; PG8_MMA(1, 1, At, B1); PG8_BAR;
            PG8_LDB(B0, 1, 0); PG8_SCHED; PG8_LDA(At, 1, 0); PG8_STAGE(PG8_SA(0, 1), a2 + hstep, voffA);
            PG8_WAIT_L(8); PG8_BAR; PG8_WAIT_L(0); PG8_MMA(0, 0, At, B0); PG8_BAR; PG8_SCHED;
            PG8_LDB(B1, 1, 1); PG8_STAGE(PG8_SB(1, 0), b3, voffB);
            PG8_BAR; PG8_WAIT_L(0); PG8_MMA(0, 1, At, B1); PG8_BAR;
            PG8_LDA(At, 1, 1); PG8_STAGE(PG8_SA(1, 0), a3, voffA);
            PG8_BAR; PG8_WAIT_L(0); PG8_MMA(1, 0, At, B0); PG8_BAR; PG8_SCHED;
            PG8_STAGE(PG8_SB(1, 1), b3 + hstep, voffB);
            PG8_WAIT_V(6); PG8_BAR; PG8_MMA(1, 1, At, B1); PG8_BAR;
            }
        }
        if constexpr (ALIGN_EPI) { if (wr == 0) PG8_BAR; }
        if constexpr (!Epi::AFTER_DRAIN) { E(acc, cur, wr, wc, fr, fq); S.done(cur); }
        if (!has_next) break;
#pragma unroll
        for (int a = 0; a < 2; ++a)
#pragma unroll
            for (int b = 0; b < 2; ++b)
#pragma unroll
                for (int m = 0; m < 4; ++m)
#pragma unroll
                    for (int n = 0; n < 2; ++n) acc[a][b][m][n] = (f32x4){0.f, 0.f, 0.f, 0.f};
        cur = nxt; cA = nA; cB = nB; ++ui;
        if constexpr (ALIGN_EPI) { if (wr == 1) PG8_BAR; }
    }
    PG8_WAIT_V(0);
    if constexpr (!ALIGN_EPI) { if (wr == 0) PG8_BAR; }
    PG8_BAR;
    if constexpr (Epi::AFTER_DRAIN) { E.fused(acc, cur, wr, wc, fr, fq, lds, wid, lane); S.done(cur); }
#undef PG8_SA
#undef PG8_SB
#undef PG8_STAGE
#undef PG8_LDA
#undef PG8_LDB
#undef PG8_MMA
#undef PG8_WAIT_V
#undef PG8_WAIT_L
#undef PG8_BAR
#undef PG8_SCHED
}
}
namespace attn_body {
using bf16=__hip_bfloat16;
using bf16x8=__attribute__((ext_vector_type(8)))short;
using s16x4=__attribute__((ext_vector_type(4)))short;
using f32x16=__attribute__((ext_vector_type(16)))float;
using u32x4=__attribute__((ext_vector_type(4)))unsigned;
constexpr int SEQ=4096,D=64,DM=2560;
constexpr int NW=8,QBLK=32,QB=QBLK*NW,KVBLK=64,NQB=SEQ/QB;
constexpr int ATTN_PITCH=DM, ATTN_UNIT_ROWS=QB;
constexpr float NEGBIG=-16384.f;
__device__ __forceinline__ int crow(int r,int hi){return (r&3)+8*(r>>2)+4*hi;}
#define SBAR() __builtin_amdgcn_sched_barrier(0)
__device__ __forceinline__ void cmask(f32x16&p0,f32x16&p1,int jb,int qrel,int hi){
  const float NEG=-INFINITY; int kb=64*jb+4*hi;
  #pragma unroll
  for(int r=0;r<16;++r){int kv=kb+(r&3)+8*(r>>2); if(kv>qrel)p0[r]=NEG; if(kv+32>qrel)p1[r]=NEG;}
}

constexpr int NSLOT=3, SLOTB=8192;
constexpr int LDS_K=0, LDS_V=NSLOT*SLOTB, LDS_WS=2*NSLOT*SLOTB, LDS_OST=LDS_WS+NW*64*4, LDS_BYTES=LDS_OST+NW*4096;
constexpr float C2=0.125f*1.4426950408889634f;
__device__ __forceinline__ void glds16(const void*gsrc,unsigned lds_dst){unsigned keep;
  asm volatile("s_mov_b32 %0, m0\n\ts_mov_b32 m0, %2\n\ts_nop 0\n\tglobal_load_lds_dwordx4 %1, off\n\ts_mov_b32 m0, %0":"=&s"(keep):"v"(gsrc),"s"(lds_dst):"memory");}
__device__ __forceinline__ float max3f(float a,float b,float c){float r;asm("v_max3_f32 %0, %1, %2, %3":"=v"(r):"v"(a),"v"(b),"v"(c));return r;}
__device__ __forceinline__ float max2f(float a,float b){float r;asm("v_max_f32_e32 %0, %1, %2":"=v"(r):"v"(a),"v"(b));return r;}
__device__ __forceinline__ float fadd_s(float a,float b){float r;asm("v_add_f32_e32 %0, %1, %2":"=v"(r):"v"(a),"v"(b));return r;}
__device__ __forceinline__ float fsub_s(float a,float b){float r;asm("v_sub_f32_e32 %0, %1, %2":"=v"(r):"v"(a),"v"(b));return r;}
typedef float f32x2_t __attribute__((ext_vector_type(2))); typedef __bf16 bf16x2_t __attribute__((ext_vector_type(2)));
__device__ __forceinline__ unsigned cvtpk_s(float lo,float hi){f32x2_t v={lo,hi};bf16x2_t b=__builtin_convertvector(v,bf16x2_t);return __builtin_bit_cast(unsigned,b);}
#define WAIT_BAR(N) asm volatile("s_waitcnt vmcnt(" #N ") lgkmcnt(0)\n\ts_barrier":::"memory")

__device__ __forceinline__ void qkt(f32x16&p0,f32x16&p1,const char*Kslot,const bf16x8*qr,const f32x16&negm,int r32,int hi){
  const char*kb=Kslot+hi*1024+r32*16;
  #pragma unroll
  for(int d0=0;d0<4;++d0){
    const bf16x8 b0=*reinterpret_cast<const bf16x8*>(kb+d0*2048);
    const bf16x8 b1=*reinterpret_cast<const bf16x8*>(kb+d0*2048+512);
    if(d0==0){p0=__builtin_amdgcn_mfma_f32_32x32x16_bf16(b0,qr[0],negm,0,0,0);p1=__builtin_amdgcn_mfma_f32_32x32x16_bf16(b1,qr[0],negm,0,0,0);}
    else{p0=__builtin_amdgcn_mfma_f32_32x32x16_bf16(b0,qr[d0],p0,0,0,0);p1=__builtin_amdgcn_mfma_f32_32x32x16_bf16(b1,qr[d0],p1,0,0,0);}}
}
typedef __attribute__((address_space(3))) const char* lds_cptr;
typedef short v4i16_t __attribute__((ext_vector_type(4)));
__device__ __forceinline__ void kload8(bf16x8*kf,lds_cptr kp){
  kf[0]=*(const __attribute__((address_space(3))) bf16x8*)(kp);      kf[1]=*(const __attribute__((address_space(3))) bf16x8*)(kp+512);
  kf[2]=*(const __attribute__((address_space(3))) bf16x8*)(kp+2048); kf[3]=*(const __attribute__((address_space(3))) bf16x8*)(kp+2560);
  kf[4]=*(const __attribute__((address_space(3))) bf16x8*)(kp+4096); kf[5]=*(const __attribute__((address_space(3))) bf16x8*)(kp+4608);
  kf[6]=*(const __attribute__((address_space(3))) bf16x8*)(kp+6144); kf[7]=*(const __attribute__((address_space(3))) bf16x8*)(kp+6656);
}
__device__ __forceinline__ void kload2(bf16x8*kf,lds_cptr kp,int j){ kf[2*j]=*(const __attribute__((address_space(3))) bf16x8*)(kp+j*2048); kf[2*j+1]=*(const __attribute__((address_space(3))) bf16x8*)(kp+j*2048+512); }
__device__ __forceinline__ s16x4 vtr(lds_cptr p){ return __builtin_bit_cast(s16x4,__builtin_amdgcn_ds_read_tr16_b64_v4i16((__attribute__((address_space(3))) v4i16_t*)p)); }
__device__ __forceinline__ float rowmax(const f32x16&p0,const f32x16&p1){
  float a=max3f(p0[0],p0[1],p1[0]),b=max3f(p0[2],p0[3],p1[1]);a=max3f(a,p1[2],p1[3]);
  #pragma unroll
  for(int r=4;r<16;r+=4){a=max3f(a,p0[r],p0[r+1]);b=max3f(b,p0[r+2],p0[r+3]);a=max3f(a,p1[r],p1[r+1]);b=max3f(b,p1[r+2],p1[r+3]);}
  const float m=max2f(a,b);
  auto rr=__builtin_amdgcn_permlane32_swap(__float_as_uint(m),__float_as_uint(m),false,false);
  return max2f(__uint_as_float(rr[0]),__uint_as_float(rr[1]));
}
__device__ __forceinline__ void pv(f32x16*o,int vb,bf16x8 pa0,bf16x8 pa1,bf16x8 pa2,bf16x8 pa3){
  #pragma unroll
  for(int d0=0;d0<2;++d0){s16x4 lo[4],hi[4];
    #pragma unroll
    for(int ks=0;ks<4;++ks){
      asm volatile("ds_read_b64_tr_b16 %0,%1 offset:%c2":"=&v"(lo[ks]):"v"(vb),"i"(d0*4096+ks*1024):"memory");
      asm volatile("ds_read_b64_tr_b16 %0,%1 offset:%c2":"=&v"(hi[ks]):"v"(vb),"i"(d0*4096+ks*1024+512):"memory");}
    asm volatile("s_waitcnt lgkmcnt(0)":::"memory");SBAR();
    #define PK(k) (bf16x8){lo[k][0],lo[k][1],lo[k][2],lo[k][3],hi[k][0],hi[k][1],hi[k][2],hi[k][3]}
    o[d0]=__builtin_amdgcn_mfma_f32_32x32x16_bf16(pa0,PK(0),o[d0],0,0,0);
    o[d0]=__builtin_amdgcn_mfma_f32_32x32x16_bf16(pa1,PK(1),o[d0],0,0,0);
    o[d0]=__builtin_amdgcn_mfma_f32_32x32x16_bf16(pa2,PK(2),o[d0],0,0,0);
    o[d0]=__builtin_amdgcn_mfma_f32_32x32x16_bf16(pa3,PK(3),o[d0],0,0,0);
    #undef PK
  }
}

#ifndef ATTN_STORE16
#define ATTN_STORE16(p,v) (*(u32x4*)(p)=(v))
#endif
template<int THRL,int BIAS,bool OUTF32> __device__ __forceinline__ void attn_unit(int b,int qb,const bf16*Q,const bf16*__restrict__ K,const bf16*__restrict__ V,float slope2,void*O,int opitch,char*shm){
  int tid_=threadIdx.x; asm volatile("":"+v"(tid_));
  const int tid=tid_,lane=tid&63,r32=lane&31,hi=lane>>5; const int wid=__builtin_amdgcn_readfirstlane(tid>>6);
  const long rowbase=(long)b*SEQ; const int q0=qb*QB;
  const bf16*Qw=Q+(rowbase+q0+wid*QBLK)*DM;
  const bf16*Kh=K+rowbase*DM,*Vh=V+rowbase*DM;
  const unsigned lds0=(unsigned)(uintptr_t)shm;
  float*wsf=(float*)(shm+LDS_WS)+wid*64;
  const bf16*ksrc=Kh+(long)lane*DM+wid*8;
  const bf16*vsrc=Vh+(long)(16*(wid&3)+(lane>>2))*DM+(wid>>2)*32+(lane&3)*8;
  const unsigned kdst=lds0+LDS_K+wid*1024, vdst=lds0+LDS_V+wid*1024;
  #define DMA_K(t,slot) glds16(ksrc+(long)(t)*KVBLK*DM,(unsigned)__builtin_amdgcn_readfirstlane(kdst+(slot)))
  #define DMA_V(t,slot) glds16(vsrc+(long)(t)*KVBLK*DM,(unsigned)__builtin_amdgcn_readfirstlane(vdst+(slot)))
  const int vb0=(int)(lds0+LDS_V)+((lane>>4)&1)*32+(lane&3)*8+(4*hi+((lane&15)>>2))*64;
  const char*Kbase=shm+LDS_K; bf16x8 kf[8];
  const lds_cptr shm3=(lds_cptr)shm; const lds_cptr kp0=shm3+LDS_K+hi*1024+r32*16; const lds_cptr vp0=shm3+LDS_V+((lane>>4)&1)*32+(lane&3)*8+(4*hi+((lane&15)>>2))*64;
  constexpr int NT=SEQ/KVBLK;
  DMA_K(0,0);DMA_V(0,0);DMA_K(1,SLOTB);
  bf16x8 qr[4];
  #pragma unroll
  for(int d0=0;d0<4;++d0)qr[d0]=*reinterpret_cast<const bf16x8*>(&Qw[(long)r32*DM+d0*16+hi*8]);
  float mhat=0.f,l_reg=0.f;f32x16 o[2];o[0]=f32x16{};o[1]=f32x16{};f32x16 negm=f32x16{};asm volatile("":"+v"(negm));
  const float qk0=(float)(q0+wid*QBLK+r32-4*hi);
  #define CMASK(P0,P1,t) do{ if(BIAS==1){ const float dl_=qk0-(float)(64*(t)); \
      _Pragma("unroll") for(int r=0;r<16;++r){ const float c_=(float)((r&3)+8*(r>>2)); P0[r]=__builtin_fmaf(-slope2,__builtin_fabsf(dl_-c_),P0[r]); P1[r]=__builtin_fmaf(-slope2,__builtin_fabsf(dl_-(c_+32.f)),P1[r]); } } }while(0)
  bool resc=false;
  #define START(P0,P1) do{ const float rm=rowmax(P0,P1); resc=false; \
    { const float dl=rm; mhat=fadd_s(mhat,dl); \
      _Pragma("unroll") for(int r=0;r<16;++r){P0[r]=fsub_s(P0[r],dl);P1[r]=fsub_s(P1[r],dl);} \
      _Pragma("unroll") for(int r=0;r<16;++r)negm[r]=-mhat; asm volatile("":"+v"(negm)); } \
    _Pragma("unroll") for(int r=0;r<16;++r)P0[r]=__builtin_amdgcn_exp2f(P0[r]); }while(0)
  #define RESC() do{ if(resc){ asm volatile("s_waitcnt lgkmcnt(0)":::"memory"); \
      _Pragma("unroll") for(int d_=0;d_<2;++d_) _Pragma("unroll") for(int r=0;r<16;++r)o[d_][r]*=wsf[crow(r,hi)]; } }while(0)
  f32x16 pA0,pA1,pB0,pB1;
  int sl_prev=0,sl_cur=0,sl_next=SLOTB;
  #define ROT() do{sl_prev=sl_cur;sl_cur=sl_next;sl_next=(sl_next==(NSLOT-1)*SLOTB)?0:sl_next+SLOTB;}while(0)
  DMA_K(2,2*SLOTB);
  WAIT_BAR(3);
  qkt(pA0,pA1,Kbase,qr,negm,r32,hi);asm volatile("s_nop 15\n\ts_nop 7":"+v"(pA0),"+v"(pA1));CMASK(pA0,pA1,0);
  START(pA0,pA1);
  _Pragma("unroll") for(int r=0;r<16;++r)pA1[r]=__builtin_amdgcn_exp2f(pA1[r]);
  WAIT_BAR(0);
  DMA_K(3,0);DMA_V(1,SLOTB);
  ROT();
  kload8(kf,kp0+sl_cur);
  WAIT_BAR(2);
  s16x4 vlo[8],vhi[8]; u32x4 pw0,pw1,pw2,pw3;
  #define PKW(P,B) cvtpk_s(P[B],P[B+1])
  #define PAF(k) __builtin_bit_cast(bf16x8,pw##k)
  #define VFR(i) (bf16x8){vlo[i][0],vlo[i][1],vlo[i][2],vlo[i][3],vhi[i][0],vhi[i][1],vhi[i][2],vhi[i][3]}
  #define PIN(x) asm volatile("":"+v"(x))
  #define MX3(a,b,c) __builtin_fmaxf(__builtin_fmaxf((a),(b)),(c))
  #define GAPA(MF,A0,A1,A2,A3,W0,W1,PW) do{ MF; sacc+=A0; sacc+=A1; sacc+=A2; sacc+=A3; PIN(sacc); W0; W1; PIN(PW); SBAR(); }while(0)
  #define EX(v) __builtin_amdgcn_exp2f(v)
  #define GAPB(MF,X,B) do{ MF; X[B]=EX(X[B]); X[B+1]=EX(X[B+1]); X[B+2]=EX(X[B+2]); X[B+3]=EX(X[B+3]); PIN(X); SBAR(); }while(0)
  #define VRD(i) do{ vlo[i]=vtr(vp_+(((i)>>2)*4096+((i)&3)*1024)); vhi[i]=vtr(vp_+(((i)>>2)*4096+((i)&3)*1024+512)); }while(0)
  #define KRD(G,j) do{ if(G){ kload2(kf,kp0+sl_next,j); SBAR(); } }while(0)
  #define STEP(C0,C1,P0,P1,t,GK,GV,GL) do{ SBAR(); \
    const lds_cptr vp_=vp0+sl_prev; \
    VRD(0); SBAR(); float sacc=(P0[0]+P0[1]); \
    GAPA(C0=__builtin_amdgcn_mfma_f32_32x32x16_bf16(kf[0],qr[0],negm,0,0,0), P0[2],P0[3],P0[4],P0[5],     pw0[0]=PKW(P0,0), pw0[1]=PKW(P0,2), pw0); \
    VRD(4); SBAR(); GAPA(C1=__builtin_amdgcn_mfma_f32_32x32x16_bf16(kf[1],qr[0],negm,0,0,0), P0[6],P0[7],P0[8],P0[9],     pw0[2]=PKW(P0,4), pw0[3]=PKW(P0,6), pw0); \
    VRD(1); SBAR(); GAPA(C0=__builtin_amdgcn_mfma_f32_32x32x16_bf16(kf[2],qr[1],C0,0,0,0),   P0[10],P0[11],P0[12],P0[13], pw1[0]=PKW(P0,8), pw1[1]=PKW(P0,10), pw1); \
    VRD(5); SBAR(); GAPA(C1=__builtin_amdgcn_mfma_f32_32x32x16_bf16(kf[3],qr[1],C1,0,0,0),   P0[14],P0[15],P1[0],P1[1],   pw1[2]=PKW(P0,12),pw1[3]=PKW(P0,14), pw1); \
    VRD(2); SBAR(); GAPA(C0=__builtin_amdgcn_mfma_f32_32x32x16_bf16(kf[4],qr[2],C0,0,0,0),   P1[2],P1[3],P1[4],P1[5],     pw2[0]=PKW(P1,0), pw2[1]=PKW(P1,2), pw2); \
    VRD(6); SBAR(); GAPA(C1=__builtin_amdgcn_mfma_f32_32x32x16_bf16(kf[5],qr[2],C1,0,0,0),   P1[6],P1[7],P1[8],P1[9],     pw2[2]=PKW(P1,4), pw2[3]=PKW(P1,6), pw2); \
    VRD(3); SBAR(); GAPA(C0=__builtin_amdgcn_mfma_f32_32x32x16_bf16(kf[6],qr[3],C0,0,0,0),   P1[10],P1[11],P1[12],P1[13], pw3[0]=PKW(P1,8), pw3[1]=PKW(P1,10), pw3); \
    VRD(7); SBAR(); GAPA(C1=__builtin_amdgcn_mfma_f32_32x32x16_bf16(kf[7],qr[3],C1,0,0,0),   P1[14],P1[15],0.f,0.f,       pw3[2]=PKW(P1,12),pw3[3]=PKW(P1,14), pw3); \
    l_reg+=sacc; \
    if(GK){DMA_K((t)+3,sl_cur);} if(GV){DMA_V((t)+1,sl_next);} \
    CMASK(C0,C1,t); \
    { float a=MX3(C0[0],C0[1],C1[0]),b=MX3(C0[2],C0[3],C1[1]); a=MX3(a,C1[2],C1[3]); \
      _Pragma("unroll") for(int r=4;r<16;r+=4){a=MX3(a,C0[r],C0[r+1]);b=MX3(b,C0[r+2],C0[r+3]);a=MX3(a,C1[r],C1[r+1]);b=MX3(b,C1[r+2],C1[r+3]);} \
      float rm=__builtin_fmaxf(a,b); { auto rr=__builtin_amdgcn_permlane32_swap(__float_as_uint(rm),__float_as_uint(rm),false,false); rm=__builtin_fmaxf(__uint_as_float(rr[0]),__uint_as_float(rr[1])); } \
      resc=false; \
      if(__builtin_expect(__any(rm>(float)THRL),0)){ const float dl=__builtin_fmaxf(rm,0.f); mhat+=dl; \
        _Pragma("unroll") for(int r=0;r<16;++r){C0[r]-=dl;C1[r]-=dl;} \
        _Pragma("unroll") for(int r=0;r<16;++r)negm[r]=-mhat; asm volatile("":"+v"(negm)); \
        const float f=__builtin_amdgcn_exp2f(-dl); l_reg*=f; if(hi==0)wsf[r32]=f; resc=true; } } \
    SBAR(); \
    GAPB(o[0]=__builtin_amdgcn_mfma_f32_32x32x16_bf16(PAF(0),VFR(0),o[0],0,0,0), C0,0); \
    GAPB(o[1]=__builtin_amdgcn_mfma_f32_32x32x16_bf16(PAF(0),VFR(4),o[1],0,0,0), C0,4); \
    KRD(GL,0); GAPB(o[0]=__builtin_amdgcn_mfma_f32_32x32x16_bf16(PAF(1),VFR(1),o[0],0,0,0), C0,8); \
    KRD(GL,1); GAPB(o[1]=__builtin_amdgcn_mfma_f32_32x32x16_bf16(PAF(1),VFR(5),o[1],0,0,0), C0,12); \
    KRD(GL,2); GAPB(o[0]=__builtin_amdgcn_mfma_f32_32x32x16_bf16(PAF(2),VFR(2),o[0],0,0,0), C1,0); \
    KRD(GL,3); GAPB(o[1]=__builtin_amdgcn_mfma_f32_32x32x16_bf16(PAF(2),VFR(6),o[1],0,0,0), C1,4); \
    GAPB(o[0]=__builtin_amdgcn_mfma_f32_32x32x16_bf16(PAF(3),VFR(3),o[0],0,0,0), C1,8); \
    GAPB(o[1]=__builtin_amdgcn_mfma_f32_32x32x16_bf16(PAF(3),VFR(7),o[1],0,0,0), C1,12); \
    }while(0)
  int t=1;
  for(;t+5<NT;t+=2){
    STEP(pB0,pB1,pA0,pA1,t,true,true,true);     WAIT_BAR(2); RESC(); ROT();
    STEP(pA0,pA1,pB0,pB1,t+1,true,true,true);   WAIT_BAR(2); RESC(); ROT();
  }
  #define ENDW(tt) do{ if((tt)+3<NT){WAIT_BAR(2);} else if((tt)+2<NT){WAIT_BAR(1);} else {WAIT_BAR(0);} }while(0)
  for(;t+1<NT;t+=2){
    STEP(pB0,pB1,pA0,pA1,t,(t+3<NT),(t+1<NT),(t+1<NT));       ENDW(t);   RESC(); ROT();
    STEP(pA0,pA1,pB0,pB1,t+1,(t+4<NT),(t+2<NT),(t+2<NT));     ENDW(t+1); RESC(); ROT();
  }
  STEP(pB0,pB1,pA0,pA1,NT-1,false,false,false); RESC();
  { float sacc=pB0[0]+pB0[1]; _Pragma("unroll") for(int r=2;r<16;++r)sacc+=pB0[r]; _Pragma("unroll") for(int r=0;r<16;++r)sacc+=pB1[r]; l_reg+=sacc;
    pw0=(u32x4){PKW(pB0,0),PKW(pB0,2),PKW(pB0,4),PKW(pB0,6)};pw1=(u32x4){PKW(pB0,8),PKW(pB0,10),PKW(pB0,12),PKW(pB0,14)};pw2=(u32x4){PKW(pB1,0),PKW(pB1,2),PKW(pB1,4),PKW(pB1,6)};pw3=(u32x4){PKW(pB1,8),PKW(pB1,10),PKW(pB1,12),PKW(pB1,14)};
    SBAR(); pv(o,vb0+sl_cur,PAF(0),PAF(1),PAF(2),PAF(3)); }
  #undef PKW
  #undef PAF
  #undef VFR
  #undef PIN
  #undef MX3
  #undef GAPA
  #undef GAPB
  #undef EX
  #undef VRD
  #undef KRD
  #undef STEP
  #undef ENDW
  {auto rr=__builtin_amdgcn_permlane32_swap(__float_as_uint(l_reg),__float_as_uint(l_reg),false,false);l_reg=__uint_as_float(rr[0])+__uint_as_float(rr[1]);}
  if(hi==0)wsf[32+r32]=l_reg;asm volatile("s_waitcnt lgkmcnt(0)":::"memory");
  float rli[16];
  #pragma unroll
  for(int r=0;r<16;++r)rli[r]=__builtin_amdgcn_rcpf(wsf[32+crow(r,hi)]);
  if(OUTF32){ float*Ow=(float*)O+(rowbase+q0+wid*QBLK)*(long)opitch;
    #pragma unroll
    for(int r=0;r<16;++r){const int orow=crow(r,hi);
      #pragma unroll
      for(int d0=0;d0<2;++d0)Ow[(long)orow*opitch+d0*32+r32]=o[d0][r]*rli[r];}
  } else { bf16*Ow=(bf16*)O+(rowbase+q0+wid*QBLK)*(long)opitch;
    bf16*stg=(bf16*)(shm+LDS_OST)+wid*2048;
    #pragma unroll
    for(int r=0;r<16;++r){const int orow=crow(r,hi);
      #pragma unroll
      for(int d0=0;d0<2;++d0)stg[orow*64+d0*32+r32]=__float2bfloat16(o[d0][r]*rli[r]);}
    asm volatile("s_waitcnt lgkmcnt(0)":::"memory");
    #pragma unroll
    for(int i=0;i<4;++i){const int row=i*8+(lane>>3),ch=lane&7; const u32x4 v=*(const u32x4*)(stg+row*64+ch*8); ATTN_STORE16(Ow+(long)row*opitch+ch*8,v);} }
  asm volatile("s_waitcnt lgkmcnt(0)\n\ts_barrier":::"memory");
  #undef DMA_K
  #undef DMA_V
  #undef CMASK
  #undef START
  #undef RESC
  #undef ROT
}
constexpr int ATTN_LDS_BYTES=LDS_BYTES;
#undef SBAR
#undef WAIT_BAR
}
#ifndef PG8_SP2
#define PG8_SP2 true
#endif
#ifndef PG8_ALIGN
#define PG8_ALIGN true
#endif
namespace cg = cooperative_groups;

constexpr int NB = 8, S = 4096, M = NB * S, D = 1024, NIN = 2560, FF = 4096, DEPTH = 2;
constexpr int PITCH = NIN;
constexpr float EPS = 1e-6f;
constexpr float LOG2E = 1.4426950408889634f;
constexpr float C2 = 0.125f * LOG2E;
constexpr int C_AQ = 0, C_AK = 512, C_AV = 1024, C_BQ = 1536, C_BK = 1792, C_BV = 1920, C_CQ = 2048, C_CK = 2304, C_CV = 2432;
constexpr int MX_A = 0, MX_B = 512, MX_C = 768;

constexpr size_t MiB = 1u << 20;
constexpr size_t WS_CTL = 0, CTL_ZERO_BYTES = 1 * MiB;
constexpr size_t WS_TRIG = 1 * MiB;
constexpr size_t WS_WIN = 2 * MiB, WS_WOUT = 12 * MiB, WS_W1 = 16 * MiB, WS_W2 = 32 * MiB;
constexpr size_t WS_XN = 48 * MiB;
constexpr size_t WS_Y = 112 * MiB;
constexpr size_t WS_PROJ = 240 * MiB;
constexpr size_t WS_MIX = 400 * MiB;
constexpr size_t WS_H = 240 * MiB;
constexpr size_t WS_END = 496 * MiB;
static_assert(WS_H + (size_t)M * FF * 2 <= WS_END && WS_MIX + (size_t)M * D * 2 <= WS_END && WS_PROJ + (size_t)M * NIN * 2 <= WS_MIX && WS_Y + (size_t)M * D * 4 <= WS_PROJ && WS_XN + (size_t)M * D * 2 <= WS_Y, "ws map");

constexpr int NWAVES = 8;
constexpr int LDS_BYTES = 147456;
#define LAS __attribute__((address_space(3)))
typedef unsigned short bf16;
typedef float f32x4 __attribute__((ext_vector_type(4)));
typedef float f32x16 __attribute__((ext_vector_type(16)));
typedef short bf16x8 __attribute__((ext_vector_type(8)));
typedef unsigned v4u __attribute__((ext_vector_type(4)));

__device__ __forceinline__ unsigned f2bf(float f) { unsigned u = __builtin_bit_cast(unsigned, f); return (u + 0x7fffu + ((u >> 16) & 1u)) >> 16; }
__device__ __forceinline__ unsigned pk2(float lo, float hi) { return f2bf(lo) | (f2bf(hi) << 16); }
__device__ __forceinline__ float bf2f(unsigned short h) { return __builtin_bit_cast(float, (unsigned)h << 16); }
__device__ __forceinline__ float wave_sum(float v) {
#pragma unroll
    for (int o = 1; o < 64; o <<= 1) v += __shfl_xor(v, o);
    return v;
}
__device__ __forceinline__ int crow(int r, int hi) { return (r & 3) + 8 * (r >> 2) + 4 * hi; }

__device__ __forceinline__ void transpose_item(const float* W, int K, int N, bf16* WT, LAS float* scr, int item, int lane) {
    const int nblk = N / 32, kb = item / nblk, nb = item % nblk, k0 = 64 * kb, n0 = 32 * nb;
#pragma unroll 8
    for (int i = 0; i < 32; ++i) { const int kk = 2 * i + (lane >> 5); scr[kk * 33 + (lane & 31)] = W[(size_t)(k0 + kk) * N + n0 + (lane & 31)]; }
    asm volatile("s_waitcnt lgkmcnt(0)" ::: "memory");
    const int c = lane & 7;
#pragma unroll
    for (int j = 0; j < 4; ++j) { const int n = (lane >> 3) + 8 * j; const LAS float* s = scr + (8 * c) * 33 + n;
        v4u o; o.x = pk2(s[0 * 33], s[1 * 33]); o.y = pk2(s[2 * 33], s[3 * 33]); o.z = pk2(s[4 * 33], s[5 * 33]); o.w = pk2(s[6 * 33], s[7 * 33]);
        *(v4u*)(WT + (size_t)(n0 + n) * K + k0 + 8 * c) = o; }
    asm volatile("s_waitcnt lgkmcnt(0)" ::: "memory");
}
__device__ __forceinline__ void rms_row_to_bf16(const float* xrow, const float* g, bf16* orow, int lane) {
    const f32x4* xr = (const f32x4*)xrow + lane; const f32x4* gr = (const f32x4*)g + lane;
    f32x4 v[4]; float s = 0.f;
#pragma unroll
    for (int j = 0; j < 4; ++j) { v[j] = xr[64 * j]; s += (v[j].x * v[j].x + v[j].y * v[j].y) + (v[j].z * v[j].z + v[j].w * v[j].w); }
    const float rstd = 1.0f / sqrtf(wave_sum(s) * (1.f / D) + EPS);
    unsigned long long* o8 = (unsigned long long*)orow + lane;
#pragma unroll
    for (int j = 0; j < 4; ++j) { const f32x4 gg = gr[64 * j];
        o8[64 * j] = (unsigned long long)pk2(v[j].x * rstd * gg.x, v[j].y * rstd * gg.y) | ((unsigned long long)pk2(v[j].z * rstd * gg.z, v[j].w * rstd * gg.w) << 32); }
}
__device__ __forceinline__ void resnorm_row(const float* yrow, const float* baserow, float* outrow, const float* gpost, const float* gnext, bf16* xnrow, int lane) {
    const f32x4* yr = (const f32x4*)yrow + lane; const f32x4* br = (const f32x4*)baserow + lane; const f32x4* gp = (const f32x4*)gpost + lane;
    f32x4 v[4]; float s = 0.f;
#pragma unroll
    for (int j = 0; j < 4; ++j) { v[j] = yr[64 * j]; s += (v[j].x * v[j].x + v[j].y * v[j].y) + (v[j].z * v[j].z + v[j].w * v[j].w); }
    const float rstd = 1.0f / sqrtf(wave_sum(s) * (1.f / D) + EPS);
    float s2 = 0.f;
#pragma unroll
    for (int j = 0; j < 4; ++j) { const f32x4 b = br[64 * j], g = gp[64 * j]; v[j] = b + v[j] * rstd * g; s2 += (v[j].x * v[j].x + v[j].y * v[j].y) + (v[j].z * v[j].z + v[j].w * v[j].w); }
    f32x4* o = (f32x4*)outrow + lane;
#pragma unroll
    for (int j = 0; j < 4; ++j) o[64 * j] = v[j];
    if (gnext) {
        const float rstd2 = 1.0f / sqrtf(wave_sum(s2) * (1.f / D) + EPS);
        const f32x4* gn = (const f32x4*)gnext + lane; unsigned long long* o8 = (unsigned long long*)xnrow + lane;
#pragma unroll
        for (int j = 0; j < 4; ++j) { const f32x4 gg = gn[64 * j];
            o8[64 * j] = (unsigned long long)pk2(v[j].x * rstd2 * gg.x, v[j].y * rstd2 * gg.y) | ((unsigned long long)pk2(v[j].z * rstd2 * gg.z, v[j].w * rstd2 * gg.w) << 32); }
    }
}
__device__ __forceinline__ void cprep_row(bf16* prow, int pos, const float* gq, const float* gk, const float* trig, int lane) {
    const int idx = (lane < 32) ? (pos >> 6) : (pos & 63); const int fi = lane & 15;
    const float c = trig[idx * 16 + fi], sn = trig[1024 + idx * 16 + fi];
    const float gqv = gq[lane], gkv = gk[lane];
#pragma unroll
    for (int slot = 0; slot < 6; ++slot) {
        const int col = (slot < 4) ? (C_CQ + slot * 64) : (C_CK + (slot - 4) * 64);
        const float x = bf2f(prow[col + lane]);
        const float ss = wave_sum(x * x);
        const float xn = x * (1.0f / sqrtf(ss * (1.f / 64.f) + EPS)) * ((slot < 4) ? gqv : gkv);
        const float pr = __shfl_xor(xn, 16);
        float y = (lane & 16) ? (xn * c + pr * sn) : (xn * c - pr * sn);
        if (slot < 4) y *= C2;
        prow[col + lane] = (bf16)f2bf(y);
    }
}

template <int DV> __device__ __forceinline__ void attn_simple_unit(const bf16* __restrict__ P, int b, int qblk, int qcol, int kcol, int vcol, float slope2, bool window, float sink2,
                                                                   float* outf, bf16* outb, int opitch, int ocol, int lane) {
    const int r32 = lane & 31, hi = lane >> 5;
    const size_t rowbase = (size_t)b * S; const int q0 = qblk * 32; const int qpos = q0 + r32;
    bf16x8 qr[4];
#pragma unroll
    for (int d0 = 0; d0 < 4; ++d0) qr[d0] = *(const bf16x8*)(P + (rowbase + q0 + r32) * PITCH + qcol + d0 * 16 + hi * 8);
    int t_lo = 0, t_hi = S / 32;
    if (window) { int lo = q0 - 128; if (lo < 0) lo = 0; int hk = q0 + 32 + 128; if (hk > S) hk = S; t_lo = lo / 32; t_hi = hk / 32; }
    const float NEG = -INFINITY;
#define ATT_SCORES(p, t) do { p = f32x16{}; \
        _Pragma("unroll") for (int d0 = 0; d0 < 4; ++d0) { const bf16x8 kf = *(const bf16x8*)(P + (rowbase + (t) * 32 + r32) * PITCH + kcol + d0 * 16 + hi * 8); \
            p = __builtin_amdgcn_mfma_f32_32x32x16_bf16(kf, qr[d0], p, 0, 0, 0); } \
        _Pragma("unroll") for (int r = 0; r < 16; ++r) { const int kpos = (t) * 32 + crow(r, hi); int dist = qpos - kpos; dist = dist < 0 ? -dist : dist; \
            float v = p[r] - slope2 * (float)dist; if (window && dist > 128) v = NEG; p[r] = v; } } while (0)
    float m = NEG, l = 0.f;
    for (int t = t_lo; t < t_hi; ++t) {
        f32x16 p; ATT_SCORES(p, t);
        float tm = p[0];
#pragma unroll
        for (int r = 1; r < 16; ++r) tm = fmaxf(tm, p[r]);
        const float mn = fmaxf(m, tm); const float mref = (mn == NEG) ? 0.f : mn;
        float s = 0.f;
#pragma unroll
        for (int r = 0; r < 16; ++r) s += exp2f(p[r] - mref);
        l = l * exp2f(m - mref) + s; m = mn;
    }
    const float m2 = __shfl_xor(m, 32), l2 = __shfl_xor(l, 32);
    const float mn = fmaxf(fmaxf(m, m2), sink2);
    l = l * exp2f(m - mn) + l2 * exp2f(m2 - mn) + exp2f(sink2 - mn);
    const float rl = 1.0f / l;
    f32x16 o[DV / 32];
#pragma unroll
    for (int i = 0; i < DV / 32; ++i) o[i] = f32x16{};
    for (int t = t_lo; t < t_hi; ++t) {
        f32x16 p; ATT_SCORES(p, t);
#pragma unroll
        for (int r = 0; r < 16; ++r) p[r] = exp2f(p[r] - mn) * rl;
        bf16x8 pa[2];
#pragma unroll
        for (int s = 0; s < 2; ++s)
#pragma unroll
            for (int j = 0; j < 8; ++j) pa[s][j] = (short)f2bf(p[8 * s + j]);
#pragma unroll
        for (int db = 0; db < DV / 32; ++db)
#pragma unroll
            for (int s = 0; s < 2; ++s) { bf16x8 vf;
#pragma unroll
                for (int j = 0; j < 8; ++j) { const int key = t * 32 + 16 * s + 8 * (j >> 2) + 4 * hi + (j & 3); vf[j] = (short)P[(rowbase + key) * PITCH + vcol + db * 32 + r32]; }
                o[db] = __builtin_amdgcn_mfma_f32_32x32x16_bf16(pa[s], vf, o[db], 0, 0, 0); }
    }
#undef ATT_SCORES
#pragma unroll
    for (int db = 0; db < DV / 32; ++db)
#pragma unroll
        for (int r = 0; r < 16; ++r) { const size_t off = (rowbase + q0 + crow(r, hi)) * (size_t)opitch + ocol + db * 32 + r32;
            if (outf) outf[off] = o[db][r]; else outb[off] = (bf16)f2bf(o[db][r]); }
}

struct Args { const float* in[17]; float* out; unsigned char* ws; int ph_lo, ph_hi; };
enum { I_X = 0, I_WIN, I_WOUT, I_GPREMIX, I_GPOSTMIX, I_LQ1, I_LK1, I_LQ2, I_LK2, I_SUBLN, I_SINK, I_CQN, I_CKN, I_GPREMLP, I_GPOSTMLP, I_W1, I_W2 };
constexpr int PH_PER_LAYER = 9, N_PHASES = 1 + DEPTH * PH_PER_LAYER;

__global__ void __launch_bounds__(NWAVES * 64, 2) fwd(Args args) {
    extern __shared__ __attribute__((aligned(16))) unsigned char lds_raw[];
    LAS unsigned char* lds = (LAS unsigned char*)lds_raw;
    cg::grid_group grid = cg::this_grid();
    for (int ph = args.ph_lo; ph < args.ph_hi; ++ph) {
        int tid_ = threadIdx.x; asm volatile("" : "+v"(tid_));
        size_t zoff_ = 0; asm volatile("" : "+s"(zoff_));
        unsigned char* ws = args.ws + zoff_;
        const int tid = tid_, lane = tid & 63, wave = __builtin_amdgcn_readfirstlane(tid >> 6);
        const int G = gridDim.x; const int bx = blockIdx.x; const int vcu = (G % 8 == 0) ? (bx % 8) * (G / 8) + bx / 8 : bx;
        const int gw = vcu * NWAVES + wave, NGW = G * NWAVES;
        const float* x = args.in[I_X]; float* out = args.out;
        float* trig = (float*)(ws + WS_TRIG);
        bf16* Win_t = (bf16*)(ws + WS_WIN); bf16* Wout_t = (bf16*)(ws + WS_WOUT); bf16* W1_t = (bf16*)(ws + WS_W1); bf16* W2_t = (bf16*)(ws + WS_W2);
        bf16* XN = (bf16*)(ws + WS_XN); float* Y = (float*)(ws + WS_Y); float* OA = (float*)(ws + WS_Y);
        bf16* PROJ = (bf16*)(ws + WS_PROJ); bf16* MIX = (bf16*)(ws + WS_MIX); bf16* HB = (bf16*)(ws + WS_H);
        if (ph == 0) {
            if (bx == 0) for (int i = tid; i < 1024; i += NWAVES * 64) { const int idx = i >> 4, k = i & 15;
                const float freq = exp2f(-(float)(2 * k) * (1.f / 32.f) * 13.287712379549449f);
                const float ang = (float)idx * freq; trig[i] = cosf(ang); trig[1024 + i] = sinf(ang); }
            LAS float* scr = (LAS float*)(lds + wave * 16384);
            constexpr int I_IN = (D / 64) * (NIN / 32), I_OUT = (D / 64) * (D / 32), I_1 = (D / 64) * (FF / 32), I_2 = (FF / 64) * (D / 32), I_LAYER = I_IN + I_OUT + I_1 + I_2;
            for (int it = gw; it < DEPTH * I_LAYER; it += NGW) {
                const int l = it / I_LAYER; int r = it % I_LAYER;
                if (r < I_IN) { transpose_item(args.in[I_WIN] + (size_t)l * D * NIN, D, NIN, Win_t + (size_t)l * NIN * D, scr, r, lane); continue; } r -= I_IN;
                if (r < I_OUT) { transpose_item(args.in[I_WOUT] + (size_t)l * D * D, D, D, Wout_t + (size_t)l * D * D, scr, r, lane); continue; } r -= I_OUT;
                if (r < I_1) { transpose_item(args.in[I_W1] + (size_t)l * D * FF, D, FF, W1_t + (size_t)l * FF * D, scr, r, lane); continue; } r -= I_1;
                transpose_item(args.in[I_W2] + (size_t)l * FF * D, FF, D, W2_t + (size_t)l * D * FF, scr, r, lane);
            }
            for (int m = gw; m < M; m += NGW) rms_row_to_bf16(x + (size_t)m * D, args.in[I_GPREMIX], XN + (size_t)m * D, lane);
            asm volatile("s_waitcnt vmcnt(0) lgkmcnt(0)" ::: "memory"); __syncthreads();
        } else {
            const int l = (ph - 1) / PH_PER_LAYER, sub = (ph - 1) % PH_PER_LAYER;
            switch (sub) {
            case 0: {
                pg8::Gemm g{XN, Win_t + (size_t)l * NIN * D, M, NIN, D}; pg8::StaticOrder So; So.init(M, NIN, G, bx);
                pg8::EpiBf16<0> E{PROJ, NIN, (1u << 0) | (1u << 1) | (1u << 6), C2};
                pg8::gemm_phase<pg8::EpiBf16<0>, pg8::StaticOrder, PG8_ALIGN, PG8_SP2>(lds, g, So, E);
            } break;
            case 1: {
                const float* gq = args.in[I_CQN] + l * 64; const float* gk = args.in[I_CKN] + l * 64;
                for (int m = gw; m < M; m += NGW) cprep_row(PROJ + (size_t)m * PITCH, m % S, gq, gk, trig, lane);
            } break;
            case 2: {
                constexpr int NQ = S / 32;
                constexpr int UA = 0, UB = NB * 4 * NQ, UC = 0;
                for (int u = vcu; u < NB * 4 * 2 * 2 * 16; u += G) { const int round = u >> 8, rem = u & 255, b = rem >> 5, j = rem & 31, qb = j & 15, vh = j >> 4, h = round >> 1, map = round & 1;
                    attn_body::attn_unit<8, 1, true>(b, qb, (const attn_body::bf16*)(PROJ + C_AQ + h * 128 + map * 64), (const attn_body::bf16*)(PROJ + C_AK + h * 128 + map * 64), (const attn_body::bf16*)(PROJ + C_AV + h * 128 + vh * 64),
                                                     exp2f(-(float)(2 * h + 1)) * LOG2E, OA + (size_t)map * M * 512 + h * 128 + vh * 64, 512, (char*)lds_raw); }
                for (int u = vcu; u < NB * 4 * 16; u += G) { const int round = u >> 8, rem = u & 255, b = rem >> 5, j = rem & 31, qb = j & 15, h = round * 2 + (j >> 4);
                    attn_body::attn_unit<8, 0, false>(b, qb, (const attn_body::bf16*)(PROJ + C_CQ + h * 64), (const attn_body::bf16*)(PROJ + C_CK + (h >> 1) * 64), (const attn_body::bf16*)(PROJ + C_CV + (h >> 1) * 64),
                                                      0.f, MIX + MX_C + h * 64, D, (char*)lds_raw); }
                for (int u = gw; u < UA + UB + UC; u += NGW) {
                    if (u < UA) { const int qb = u % NQ, s = u / NQ, map = s & 1, h = (s >> 1) & 3, b = s >> 3;
                        attn_simple_unit<128>(PROJ, b, qb, C_AQ + h * 128 + map * 64, C_AK + h * 128 + map * 64, C_AV + h * 128, exp2f(-(float)(2 * h + 1)) * LOG2E, false, -INFINITY,
                                              OA + (size_t)map * M * 512, nullptr, 512, h * 128, lane);
                    } else if (u < UA + UB) { const int v = u - UA; const int qb = v % NQ, s = v / NQ, h = s & 3, b = s >> 2;
                        attn_simple_unit<64>(PROJ, b, qb, C_BQ + h * 64, C_BK + (h >> 1) * 64, C_BV + (h >> 1) * 64, exp2f(-(float)(2 * h + 2)) * LOG2E, true, args.in[I_SINK][l * 4 + h] * LOG2E,
                                             nullptr, MIX, D, MX_B + h * 64, lane);
                    } else { const int v = u - UA - UB; const int qb = v % NQ, s = v / NQ, h = s & 3, b = s >> 2;
                        attn_simple_unit<64>(PROJ, b, qb, C_CQ + h * 64, C_CK + (h >> 1) * 64, C_CV + (h >> 1) * 64, 0.f, false, -INFINITY,
                                             nullptr, MIX, D, MX_C + h * 64, lane);
                    }
                }
            } break;
            case 3: {
                const float lam_init = 0.8f - 0.6f * expf(-0.3f * (float)l);
                const float d1 = wave_sum(args.in[I_LQ1][l * 64 + lane] * args.in[I_LK1][l * 64 + lane]);
                const float d2 = wave_sum(args.in[I_LQ2][l * 64 + lane] * args.in[I_LK2][l * 64 + lane]);
                const float lam = expf(d1) - expf(d2) + lam_init;
                const float g0 = args.in[I_SUBLN][l * 128 + 2 * lane] * (1.f - lam_init), g1 = args.in[I_SUBLN][l * 128 + 2 * lane + 1] * (1.f - lam_init);
                for (int it = gw; it < M * 4; it += NGW) { const int m = it >> 2, h = it & 3; const size_t off = (size_t)m * 512 + h * 128 + 2 * lane;
                    const float2 a = *(const float2*)(OA + off), c = *(const float2*)(OA + (size_t)M * 512 + off);
                    const float o0 = a.x - lam * c.x, o1 = a.y - lam * c.y;
                    const float rstd = 1.0f / sqrtf(wave_sum(o0 * o0 + o1 * o1) * (1.f / 128.f) + EPS);
                    *(unsigned*)(MIX + (size_t)m * D + MX_A + h * 128 + 2 * lane) = pk2(o0 * rstd * g0, o1 * rstd * g1); }
            } break;
            case 4: {
                pg8::Gemm g{MIX, Wout_t + (size_t)l * D * D, M, D, D}; pg8::StaticOrder So; So.init(M, D, G, bx);
                pg8::EpiF32 E{Y, D};
                pg8::gemm_phase<pg8::EpiF32, pg8::StaticOrder, PG8_ALIGN, PG8_SP2>(lds, g, So, E);
            } break;
            case 5: {
                const float* base = (l == 0) ? x : out;
                for (int m = gw; m < M; m += NGW) resnorm_row(Y + (size_t)m * D, base + (size_t)m * D, out + (size_t)m * D, args.in[I_GPOSTMIX] + l * D, args.in[I_GPREMLP] + l * D, XN + (size_t)m * D, lane);
            } break;
            case 6: {
                pg8::Gemm g{XN, W1_t + (size_t)l * FF * D, M, FF, D}; pg8::StaticOrder So; So.init(M, FF, G, bx);
                pg8::EpiBf16<1> E{HB, FF, 0u, 1.f};
                pg8::gemm_phase<pg8::EpiBf16<1>, pg8::StaticOrder, PG8_ALIGN, PG8_SP2>(lds, g, So, E);
            } break;
            case 7: {
                pg8::Gemm g{HB, W2_t + (size_t)l * D * FF, M, D, FF}; pg8::StaticOrder So; So.init(M, D, G, bx);
                pg8::EpiF32 E{Y, D};
                pg8::gemm_phase<pg8::EpiF32, pg8::StaticOrder, PG8_ALIGN, PG8_SP2>(lds, g, So, E);
            } break;
            default: {
                const float* gnext = (l + 1 < DEPTH) ? args.in[I_GPREMIX] + (l + 1) * D : nullptr;
                for (int m = gw; m < M; m += NGW) resnorm_row(Y + (size_t)m * D, out + (size_t)m * D, out + (size_t)m * D, args.in[I_GPOSTMLP] + l * D, gnext, XN + (size_t)m * D, lane);
            } break;
            }
        }
        if (ph + 1 < args.ph_hi) grid.sync();
    }
}

#ifndef MK_ONE_LAUNCH
#define MK_ONE_LAUNCH 1
#endif
extern "C" void kernel_launch(void* const* d_in, const int* in_sizes, int n_in, void* d_out, int out_size, void* d_ws, size_t ws_size, hipStream_t stream) {
    static int grid = 0;
    if (grid == 0) {
        if (n_in != 17 || in_sizes[0] != M * D || out_size != M * D || ws_size < WS_END) { fprintf(stderr, "kernel_launch: unexpected shapes (n_in %d, in0 %d, out %d, ws %zu); nothing launched\n", n_in, n_in > 0 ? in_sizes[0] : -1, out_size, ws_size); grid = -1; return; }
        int dev = 0, cus = 0, per_cu = 0;
        if (hipGetDevice(&dev) != hipSuccess || hipDeviceGetAttribute(&cus, hipDeviceAttributeMultiprocessorCount, dev) != hipSuccess) { grid = -1; return; }
        if (hipFuncSetAttribute((const void*)fwd, hipFuncAttributeMaxDynamicSharedMemorySize, LDS_BYTES) != hipSuccess) { fprintf(stderr, "kernel_launch: hipFuncSetAttribute failed\n"); grid = -1; return; }
        if (hipOccupancyMaxActiveBlocksPerMultiprocessor(&per_cu, (const void*)fwd, NWAVES * 64, LDS_BYTES) != hipSuccess || per_cu < 1) { fprintf(stderr, "kernel_launch: occupancy query says %d blocks per CU\n", per_cu); per_cu = 1; }
        (void)hipGetLastError();
        grid = cus;
    }
    if (grid < 0) return;
    Args a{};
    for (int i = 0; i < 17; ++i) a.in[i] = (const float*)d_in[i];
    a.out = (float*)d_out; a.ws = (unsigned char*)d_ws;
#if MK_ONE_LAUNCH
    a.ph_lo = 0; a.ph_hi = N_PHASES;
    void* kargs[] = {&a};
    hipError_t e = hipLaunchCooperativeKernel((const void*)fwd, dim3(grid), dim3(NWAVES * 64), kargs, LDS_BYTES, stream);
    if (e != hipSuccess) fprintf(stderr, "kernel_launch: cooperative launch failed: %s (grid %d)\n", hipGetErrorString(e), grid);
#else
    for (int ph = 0; ph < N_PHASES; ++ph) { a.ph_lo = ph; a.ph_hi = ph + 1;
        hipLaunchKernelGGL(fwd, dim3(grid), dim3(NWAVES * 64), LDS_BYTES, stream, a);
        const hipError_t le = hipPeekAtLastError();
        if (le != hipSuccess) { fprintf(stderr, "kernel_launch: launch %d failed: %s\n", ph, hipGetErrorName(le)); break; } }
#endif
}
```

```cpp
#include <hip/hip_runtime.h>
#include <hip/hip_cooperative_groups.h>
#include <hip/hip_bf16.h>
#include <cstdio>
#include <cstdint>
#include <cmath>
namespace pg8 {
#define PG8_LAS __attribute__((address_space(3)))
typedef unsigned short bf16_t;
typedef short bf16x8 __attribute__((ext_vector_type(8)));
typedef float f32x4 __attribute__((ext_vector_type(4)));
typedef unsigned u32x4 __attribute__((ext_vector_type(4)));
constexpr int BM = 256, BK = 64, HALF = 128, HTB = HALF * BK * 2  , STAGE_BYTES = 8 * HTB, NXCD = 8, WGM = 8;

__host__ __device__ __forceinline__ int lds_byte(int r, int c) { const int st = (r >> 4) * 2 + (c >> 5), rr = r & 15, cc = c & 31, ob = rr * 64 + cc * 2; return st * 1024 + (ob ^ (((ob >> 9) & 1) << 5)); }
__host__ __device__ __forceinline__ void stage_rc(int b, int& R, int& C) { const int st = b / 1024, sb = b % 1024, swz = sb ^ (((sb >> 9) & 1) << 5); R = (st >> 1) * 16 + swz / 64; C = (st & 1) * 32 + (swz % 64) / 2; }
__host__ __device__ __forceinline__ int perm32(int rho) { const int n = rho >> 4, i = rho & 15; return 8 * (i >> 2) + 4 * n + (i & 3); }

struct Unit { int pm, pn; };
struct Gemm { const bf16_t* A; const bf16_t* Bt; int M, N, K; };

struct StaticOrder {
    int nM, nN, nwg, G, c;
    __host__ __device__ void init(int M, int N, int G_, int c_) { nM = M / BM; nN = N / BM; nwg = nM * nN; G = G_; c = c_; }
    __host__ __device__ bool next(int i, Unit& u) const {
        const long L = (long)i * G + c; if (L >= nwg) return false;
        int wgid = (int)L; { const int q = nwg / NXCD, r = nwg % NXCD, xcd = wgid % NXCD, off = wgid / NXCD; wgid = (xcd < r ? xcd * (q + 1) : r * (q + 1) + (xcd - r) * q) + off; }
        const int nig = WGM * nN, gid = wgid / nig, fm = gid * WGM, gsz = (nM - fm) < WGM ? (nM - fm) : WGM;
        u.pm = fm + ((wgid % nig) % gsz); u.pn = (wgid % nig) / gsz; return true;
    }
    __device__ __forceinline__ void a_ready(const Unit&) const {}
    __device__ __forceinline__ void done(const Unit&) const {}
};

__device__ __forceinline__ unsigned cvt_pk_bf16(float lo, float hi) { unsigned r; asm volatile("v_cvt_pk_bf16_f32 %0, %1, %2" : "=v"(r) : "v"(lo), "v"(hi)); return r; }
template <int ACT  > struct EpiBf16 {
    static constexpr bool PERM = true, AFTER_DRAIN = false;
    bf16_t* O; int ldc; unsigned scale_mask; float scale;
    __device__ __forceinline__ void operator()(const f32x4 (&acc)[2][2][4][2], const Unit& u, int wr, int wc, int fr, int fq) const {
        const int row0 = u.pm * BM + wr * 64 + fr; const int col0 = u.pn * BM + wc * 32 + 8 * fq;
        const float sc = ((scale_mask >> u.pn) & 1u) ? scale : 1.f;
#pragma unroll
        for (int ai = 0; ai < 2; ++ai)
#pragma unroll
            for (int m = 0; m < 4; ++m) { bf16_t* rowp = O + (size_t)(row0 + ai * HALF + m * 16) * ldc + col0;
#pragma unroll
                for (int bj = 0; bj < 2; ++bj) { f32x4 v0 = acc[ai][bj][m][0], v1 = acc[ai][bj][m][1];
                    if (ACT == 1) {
#pragma unroll
                        for (int e = 0; e < 4; ++e) { const float a = fmaxf(v0[e], 0.f), b = fmaxf(v1[e], 0.f); v0[e] = a * a; v1[e] = b * b; } }
                    v0 = v0 * sc; v1 = v1 * sc; u32x4 w; w.x = cvt_pk_bf16(v0[0], v0[1]); w.y = cvt_pk_bf16(v0[2], v0[3]); w.z = cvt_pk_bf16(v1[0], v1[1]); w.w = cvt_pk_bf16(v1[2], v1[3]);
                    *(u32x4*)(rowp + bj * HALF) = w; } }
    }
};
struct EpiF32 {
    static constexpr bool PERM = false, AFTER_DRAIN = false;
    float* O; int ldc;
    __device__ __forceinline__ void operator()(const f32x4 (&acc)[2][2][4][2], const Unit& u, int wr, int wc, int fr, int fq) const {
        const int col0 = u.pn * BM + wc * 32 + 4 * fq;
#pragma unroll
        for (int ai = 0; ai < 2; ++ai)
#pragma unroll
            for (int m = 0; m < 4; ++m) { const size_t off = (size_t)(u.pm * BM + ai * HALF + wr * 64 + m * 16 + fr) * ldc + col0;
#pragma unroll
                for (int bj = 0; bj < 2; ++bj)
#pragma unroll
                    for (int n = 0; n < 2; ++n) *(f32x4*)(O + off + bj * HALF + n * 16) = acc[ai][bj][m][n]; }
    }
};
template <class Epi, class Sched, bool ALIGN_EPI = false, bool SP2 = false>
__device__ __forceinline__ void gemm_phase(PG8_LAS unsigned char* lds, const Gemm g, const Sched& S, const Epi& E) {
    int tid_ = threadIdx.x; asm volatile("" : "+v"(tid_));
    const int tid = tid_, wid = __builtin_amdgcn_readfirstlane(tid >> 6), lane = tid & 63, wr = wid >> 2, wc = wid & 3, fr = lane & 15, fq = lane >> 4;
    const int K = g.K, nt = K / BK;
    unsigned voffA[2], voffB[2];
#pragma unroll
    for (int i = 0; i < 2; ++i) { int R, C; stage_rc(tid * 16 + i * 8192, R, C); const int Rb = Epi::PERM ? ((R & ~31) + perm32(R & 31)) : R;
        voffA[i] = (unsigned)(R * K + C) * 2u; voffB[i] = (unsigned)(Rb * K + C) * 2u; }
    const size_t kstep = (size_t)(BK * 2);
    const size_t hstep = (size_t)HALF * K * 2;
    const size_t tstep = 2 * hstep;
    const unsigned ldsw = (unsigned)wid * 1024u;
    const int aoff = lds_byte(wr * 64 + fr, fq * 8), boff = lds_byte(wc * 32 + fr, fq * 8);
#define PG8_SA(b, h) (((b) * 2 + (h)) * HTB)
#define PG8_SB(b, h) ((4 + (b) * 2 + (h)) * HTB)
#define PG8_STAGE(bufoff, gbase, voff) do { _Pragma("unroll") for (int _i = 0; _i < 2; ++_i) \
        __builtin_amdgcn_global_load_lds((const unsigned*)((const char*)(gbase) + (voff)[_i]), (PG8_LAS unsigned*)(lds + (bufoff) + ldsw + _i * 8192), 16, 0, 0); } while (0)
#define PG8_LDA(dst, b, h) do { _Pragma("unroll") for (int m = 0; m < 4; ++m) _Pragma("unroll") for (int k = 0; k < 2; ++k) dst[m][k] = *(const PG8_LAS bf16x8*)(lds + PG8_SA(b, h) + aoff + m * 2048 + k * 1024); } while (0)
#define PG8_LDB(dst, b, h) do { _Pragma("unroll") for (int n = 0; n < 2; ++n) _Pragma("unroll") for (int k = 0; k < 2; ++k) dst[n][k] = *(const PG8_LAS bf16x8*)(lds + PG8_SB(b, h) + boff + n * 2048 + k * 1024); } while (0)
#define PG8_MMA(ai, bj, At, Bt) do { __builtin_amdgcn_s_setprio(1); _Pragma("unroll") for (int m = 0; m < 4; ++m) _Pragma("unroll") for (int n = 0; n < 2; ++n) _Pragma("unroll") for (int k = 0; k < 2; ++k) \
        acc[ai][bj][m][n] = __builtin_amdgcn_mfma_f32_16x16x32_bf16(Bt[n][k], At[m][k], acc[ai][bj][m][n], 0, 0, 0); __builtin_amdgcn_s_setprio(0); } while (0)
#define PG8_WAIT_V(n) asm volatile("s_waitcnt vmcnt(" #n ")" ::: "memory")
#define PG8_WAIT_L(n) asm volatile("s_waitcnt lgkmcnt(" #n ")" ::: "memory")
#define PG8_BAR __builtin_amdgcn_s_barrier()
#define PG8_SCHED __builtin_amdgcn_sched_barrier(0)
    Unit cur, nxt; int ui = 0;
    if (!S.next(0, cur)) return;
    f32x4 acc[2][2][4][2];
#pragma unroll
    for (int a = 0; a < 2; ++a)
#pragma unroll
        for (int b = 0; b < 2; ++b)
#pragma unroll
            for (int m = 0; m < 4; ++m)
#pragma unroll
                for (int n = 0; n < 2; ++n) acc[a][b][m][n] = (f32x4){0.f, 0.f, 0.f, 0.f};
    bf16x8 At[4][2], B0[2][2], B1[2][2];
    const char* cA = (const char*)g.A + (size_t)cur.pm * tstep; const char* cB = (const char*)g.Bt + (size_t)cur.pn * tstep;
    S.a_ready(cur);
    if constexpr (SP2) {
        PG8_STAGE(PG8_SB(0, 0), cB, voffB); PG8_STAGE(PG8_SB(0, 1), cB + hstep, voffB); PG8_STAGE(PG8_SA(0, 0), cA, voffA); PG8_STAGE(PG8_SA(0, 1), cA + hstep, voffA);
        if (wr == 1) PG8_BAR;
        PG8_WAIT_V(2); PG8_BAR;
        PG8_STAGE(PG8_SB(1, 0), cB + kstep, voffB); PG8_STAGE(PG8_SA(1, 0), cA + kstep, voffA); PG8_STAGE(PG8_SB(1, 1), cB + hstep + kstep, voffB);
        PG8_WAIT_V(6); PG8_BAR;
    } else {
        PG8_STAGE(PG8_SB(0, 0), cB, voffB); PG8_STAGE(PG8_SA(0, 0), cA, voffA); PG8_STAGE(PG8_SB(0, 1), cB + hstep, voffB); PG8_STAGE(PG8_SA(0, 1), cA + hstep, voffA);
        if (wr == 1) PG8_BAR;
        PG8_WAIT_V(4); PG8_BAR;
        PG8_STAGE(PG8_SB(1, 0), cB + kstep, voffB); PG8_STAGE(PG8_SA(1, 0), cA + kstep, voffA); PG8_STAGE(PG8_SB(1, 1), cB + hstep + kstep, voffB);
        PG8_WAIT_V(6); PG8_BAR;
    }
    for (;;) {
        const bool has_next = S.next(ui + 1, nxt);
        const char* nA = has_next ? (const char*)g.A + (size_t)nxt.pm * tstep : cA; const char* nB = has_next ? (const char*)g.Bt + (size_t)nxt.pn * tstep : cB;
        for (int t = 0; t < nt; t += 2) {
            const bool last = (t == nt - 2);
            const char* a1 = cA + (size_t)(t + 1) * kstep;
            const char* a2 = last ? nA : cA + (size_t)(t + 2) * kstep; const char* b2 = last ? nB : cB + (size_t)(t + 2) * kstep;
            const char* a3 = a2 + kstep; const char* b3 = b2 + kstep;
            if (last && has_next) S.a_ready(nxt);
            if constexpr (SP2) {
            PG8_LDB(B0, 0, 0); PG8_LDB(B1, 0, 1); PG8_SCHED; PG8_LDA(At, 0, 0); PG8_STAGE(PG8_SA(1, 1), a1 + hstep, voffA);
            PG8_WAIT_V(8); PG8_WAIT_L(0); PG8_BAR; PG8_MMA(0, 0, At, B0); PG8_MMA(0, 1, At, B1); PG8_BAR; PG8_SCHED;
            PG8_LDA(At, 0, 1); PG8_STAGE(PG8_SB(0, 0), b2, voffB); PG8_STAGE(PG8_SB(0, 1), b2 + hstep, voffB); PG8_STAGE(PG8_SA(0, 0), a2, voffA);
            PG8_WAIT_V(8); PG8_WAIT_L(0); PG8_BAR; PG8_MMA(1, 0, At, B0); PG8_MMA(1, 1, At, B1); PG8_BAR; PG8_SCHED;
            PG8_LDB(B0, 1, 0); PG8_LDB(B1, 1, 1); PG8_SCHED; PG8_LDA(At, 1, 0); PG8_STAGE(PG8_SA(0, 1), a2 + hstep, voffA);
            PG8_WAIT_V(8); PG8_WAIT_L(0); PG8_BAR; PG8_MMA(0, 0, At, B0); PG8_MMA(0, 1, At, B1); PG8_BAR; PG8_SCHED;
            PG8_LDA(At, 1, 1); PG8_STAGE(PG8_SB(1, 0), b3, voffB); PG8_STAGE(PG8_SB(1, 1), b3 + hstep, voffB); PG8_STAGE(PG8_SA(1, 0), a3, voffA);
            PG8_WAIT_V(8); PG8_WAIT_L(0); PG8_BAR; PG8_MMA(1, 0, At, B0); PG8_MMA(1, 1, At, B1); PG8_BAR; PG8_SCHED;
            } else {
            PG8_LDB(B0, 0, 0); PG8_SCHED; PG8_LDA(At, 0, 0); PG8_STAGE(PG8_SA(1, 1), a1 + hstep, voffA);
            PG8_WAIT_L(8); PG8_BAR; PG8_WAIT_L(0); PG8_MMA(0, 0, At, B0); PG8_BAR; PG8_SCHED;
            PG8_LDB(B1, 0, 1); PG8_STAGE(PG8_SB(0, 0), b2, voffB);
            PG8_BAR; PG8_WAIT_L(0); PG8_MMA(0, 1, At, B1); PG8_BAR;
            PG8_LDA(At, 0, 1); PG8_STAGE(PG8_SA(0, 0), a2, voffA);
            PG8_BAR; PG8_WAIT_L(0); PG8_MMA(1, 0, At, B0); PG8_BAR; PG8_SCHED;
            PG8_STAGE(PG8_SB(0, 1), b2 + hstep, voffB);
            PG8_WAIT_V(6); PG8_BAR; PG8_MMA(1, 1, At, B1); PG8_BAR;
            PG8_LDB(B0, 1, 0); PG8_SCHED; PG8_LDA(At, 1, 0); PG8_STAGE(PG8_SA(0, 1), a2 + hstep, voffA);
            PG8_WAIT_L(8); PG8_BAR; PG8_WAIT_L(0); PG8_MMA(0, 0, At, B0); PG8_BAR; PG8_SCHED;
            PG8_LDB(B1, 1, 1); PG8_STAGE(PG8_SB(1, 0), b3, voffB);
            PG8_BAR; PG8_WAIT_L(0); PG8_MMA(0, 1, At, B1); PG8_BAR;
            PG8_LDA(At, 1, 1); PG8_STAGE(PG8_SA(1, 0), a3, voffA);
            PG8_BAR; PG8_WAIT_L(0); PG8_MMA(1, 0, At, B0); PG8_BAR; PG8_SCHED;
            PG8_STAGE(PG8_SB(1, 1), b3 + hstep, voffB);
            PG8_WAIT_V(6); PG8_BAR; PG8_MMA(1, 1, At, B1); PG8_BAR;
            }
        }
        if constexpr (ALIGN_EPI) { if (wr == 0) PG8_BAR; }
        if constexpr (!Epi::AFTER_DRAIN) { E(acc, cur, wr, wc, fr, fq); S.done(cur); }
        if (!has_next) break;
#pragma unroll
        for (int a = 0; a < 2; ++a)
#pragma unroll
            for (int b = 0; b < 2; ++b)
#pragma unroll
                for (int m = 0; m < 4; ++m)
#pragma unroll
                    for (int n = 0; n < 2; ++n) acc[a][b][m][n] = (f32x4){0.f, 0.f, 0.f, 0.f};
        cur = nxt; cA = nA; cB = nB; ++ui;
        if constexpr (ALIGN_EPI) { if (wr == 1) PG8_BAR; }
    }
    PG8_WAIT_V(0);
    if constexpr (!ALIGN_EPI) { if (wr == 0) PG8_BAR; }
    PG8_BAR;
    if constexpr (Epi::AFTER_DRAIN) { E.fused(acc, cur, wr, wc, fr, fq, lds, wid, lane); S.done(cur); }
#undef PG8_SA
#undef PG8_SB
#undef PG8_STAGE
#undef PG8_LDA
#undef PG8_LDB
#undef PG8_MMA
#undef PG8_WAIT_V
#undef PG8_WAIT_L
#undef PG8_BAR
#undef PG8_SCHED
}
}
namespace attn_body {
using bf16=__hip_bfloat16;
using bf16x8=__attribute__((ext_vector_type(8)))short;
using s16x4=__attribute__((ext_vector_type(4)))short;
using f32x16=__attribute__((ext_vector_type(16)))float;
using u32x4=__attribute__((ext_vector_type(4)))unsigned;
constexpr int SEQ=4096,D=64,DM=2560;
constexpr int NW=8,QBLK=32,QB=QBLK*NW,KVBLK=64,NQB=SEQ/QB;
constexpr int ATTN_PITCH=DM, ATTN_UNIT_ROWS=QB;
constexpr float NEGBIG=-16384.f;
__device__ __forceinline__ int crow(int r,int hi){return (r&3)+8*(r>>2)+4*hi;}
#define SBAR() __builtin_amdgcn_sched_barrier(0)
__device__ __forceinline__ void cmask(f32x16&p0,f32x16&p1,int jb,int qrel,int hi){
  const float NEG=-INFINITY; int kb=64*jb+4*hi;
  #pragma unroll
  for(int r=0;r<16;++r){int kv=kb+(r&3)+8*(r>>2); if(kv>qrel)p0[r]=NEG; if(kv+32>qrel)p1[r]=NEG;}
}

constexpr int NSLOT=3, SLOTB=8192;
constexpr int LDS_K=0, LDS_V=NSLOT*SLOTB, LDS_WS=2*NSLOT*SLOTB, LDS_OST=LDS_WS+NW*64*4, LDS_BYTES=LDS_OST+NW*4096;
constexpr float C2=0.125f*1.4426950408889634f;
__device__ __forceinline__ void glds16(const void*gsrc,unsigned lds_dst){unsigned keep;
  asm volatile("s_mov_b32 %0, m0\n\ts_mov_b32 m0, %2\n\ts_nop 0\n\tglobal_load_lds_dwordx4 %1, off\n\ts_mov_b32 m0, %0":"=&s"(keep):"v"(gsrc),"s"(lds_dst):"memory");}
__device__ __forceinline__ float max3f(float a,float b,float c){float r;asm("v_max3_f32 %0, %1, %2, %3":"=v"(r):"v"(a),"v"(b),"v"(c));return r;}
__device__ __forceinline__ float max2f(float a,float b){float r;asm("v_max_f32_e32 %0, %1, %2":"=v"(r):"v"(a),"v"(b));return r;}
__device__ __forceinline__ float fadd_s(float a,float b){float r;asm("v_add_f32_e32 %0, %1, %2":"=v"(r):"v"(a),"v"(b));return r;}
__device__ __forceinline__ float fsub_s(float a,float b){float r;asm("v_sub_f32_e32 %0, %1, %2":"=v"(r):"v"(a),"v"(b));return r;}
typedef float f32x2_t __attribute__((ext_vector_type(2))); typedef __bf16 bf16x2_t __attribute__((ext_vector_type(2)));
__device__ __forceinline__ unsigned cvtpk_s(float lo,float hi){f32x2_t v={lo,hi};bf16x2_t b=__builtin_convertvector(v,bf16x2_t);return __builtin_bit_cast(unsigned,b);}
#define WAIT_BAR(N) asm volatile("s_waitcnt vmcnt(" #N ") lgkmcnt(0)\n\ts_barrier":::"memory")

__device__ __forceinline__ void qkt(f32x16&p0,f32x16&p1,const char*Kslot,const bf16x8*qr,const f32x16&negm,int r32,int hi){
  const char*kb=Kslot+hi*1024+r32*16;
  #pragma unroll
  for(int d0=0;d0<4;++d0){
    const bf16x8 b0=*reinterpret_cast<const bf16x8*>(kb+d0*2048);
    const bf16x8 b1=*reinterpret_cast<const bf16x8*>(kb+d0*2048+512);
    if(d0==0){p0=__builtin_amdgcn_mfma_f32_32x32x16_bf16(b0,qr[0],negm,0,0,0);p1=__builtin_amdgcn_mfma_f32_32x32x16_bf16(b1,qr[0],negm,0,0,0);}
    else{p0=__builtin_amdgcn_mfma_f32_32x32x16_bf16(b0,qr[d0],p0,0,0,0);p1=__builtin_amdgcn_mfma_f32_32x32x16_bf16(b1,qr[d0],p1,0,0,0);}}
}
typedef __attribute__((address_space(3))) const char* lds_cptr;
typedef short v4i16_t __attribute__((ext_vector_type(4)));
__device__ __forceinline__ void kload8(bf16x8*kf,lds_cptr kp){
  kf[0]=*(const __attribute__((address_space(3))) bf16x8*)(kp);      kf[1]=*(const __attribute__((address_space(3))) bf16x8*)(kp+512);
  kf[2]=*(const __attribute__((address_space(3))) bf16x8*)(kp+2048); kf[3]=*(const __attribute__((address_space(3))) bf16x8*)(kp+2560);
  kf[4]=*(const __attribute__((address_space(3))) bf16x8*)(kp+4096); kf[5]=*(const __attribute__((address_space(3))) bf16x8*)(kp+4608);
  kf[6]=*(const __attribute__((address_space(3))) bf16x8*)(kp+6144); kf[7]=*(const __attribute__((address_space(3))) bf16x8*)(kp+6656);
}
__device__ __forceinline__ void kload2(bf16x8*kf,lds_cptr kp,int j){ kf[2*j]=*(const __attribute__((address_space(3))) bf16x8*)(kp+j*2048); kf[2*j+1]=*(const __attribute__((address_space(3))) bf16x8*)(kp+j*2048+512); }
__device__ __forceinline__ s16x4 vtr(lds_cptr p){ return __builtin_bit_cast(s16x4,__builtin_amdgcn_ds_read_tr16_b64_v4i16((__attribute__((address_space(3))) v4i16_t*)p)); }
__device__ __forceinline__ float rowmax(const f32x16&p0,const f32x16&p1){
  float a=max3f(p0[0],p0[1],p1[0]),b=max3f(p0[2],p0[3],p1[1]);a=max3f(a,p1[2],p1[3]);
  #pragma unroll
  for(int r=4;r<16;r+=4){a=max3f(a,p0[r],p0[r+1]);b=max3f(b,p0[r+2],p0[r+3]);a=max3f(a,p1[r],p1[r+1]);b=max3f(b,p1[r+2],p1[r+3]);}
  const float m=max2f(a,b);
  auto rr=__builtin_amdgcn_permlane32_swap(__float_as_uint(m),__float_as_uint(m),false,false);
  return max2f(__uint_as_float(rr[0]),__uint_as_float(rr[1]));
}
__device__ __forceinline__ void pv(f32x16*o,int vb,bf16x8 pa0,bf16x8 pa1,bf16x8 pa2,bf16x8 pa3){
  #pragma unroll
  for(int d0=0;d0<2;++d0){s16x4 lo[4],hi[4];
    #pragma unroll
    for(int ks=0;ks<4;++ks){
      asm volatile("ds_read_b64_tr_b16 %0,%1 offset:%c2":"=&v"(lo[ks]):"v"(vb),"i"(d0*4096+ks*1024):"memory");
      asm volatile("ds_read_b64_tr_b16 %0,%1 offset:%c2":"=&v"(hi[ks]):"v"(vb),"i"(d0*4096+ks*1024+512):"memory");}
    asm volatile("s_waitcnt lgkmcnt(0)":::"memory");SBAR();
    #define PK(k) (bf16x8){lo[k][0],lo[k][1],lo[k][2],lo[k][3],hi[k][0],hi[k][1],hi[k][2],hi[k][3]}
    o[d0]=__builtin_amdgcn_mfma_f32_32x32x16_bf16(pa0,PK(0),o[d0],0,0,0);
    o[d0]=__builtin_amdgcn_mfma_f32_32x32x16_bf16(pa1,PK(1),o[d0],0,0,0);
    o[d0]=__builtin_amdgcn_mfma_f32_32x32x16_bf16(pa2,PK(2),o[d0],0,0,0);
    o[d0]=__builtin_amdgcn_mfma_f32_32x32x16_bf16(pa3,PK(3),o[d0],0,0,0);
    #undef PK
  }
}

#ifndef ATTN_STORE16
#define ATTN_STORE16(p,v) (*(u32x4*)(p)=(v))
#endif
template<int THRL,int BIAS,bool OUTF32> __device__ __forceinline__ void attn_unit(int b,int qb,const bf16*Q,const bf16*__restrict__ K,const bf16*__restrict__ V,float slope2,void*O,int opitch,char*shm,int T0,int NT){
  int tid_=threadIdx.x; asm volatile("":"+v"(tid_));
  const int tid=tid_,lane=tid&63,r32=lane&31,hi=lane>>5; const int wid=__builtin_amdgcn_readfirstlane(tid>>6);
  const long rowbase=(long)b*SEQ; const int q0=qb*QB;
  const bf16*Qw=Q+(rowbase+q0+wid*QBLK)*DM;
  const bf16*Kh=K+(rowbase+(long)T0*KVBLK)*DM,*Vh=V+(rowbase+(long)T0*KVBLK)*DM;
  const unsigned lds0=(unsigned)(uintptr_t)shm;
  float*wsf=(float*)(shm+LDS_WS)+wid*64;
  const bf16*ksrc=Kh+(long)lane*DM+wid*8;
  const bf16*vsrc=Vh+(long)(16*(wid&3)+(lane>>2))*DM+(wid>>2)*32+(lane&3)*8;
  const unsigned kdst=lds0+LDS_K+wid*1024, vdst=lds0+LDS_V+wid*1024;
  #define DMA_K(t,slot) glds16(ksrc+(long)(t)*KVBLK*DM,(unsigned)__builtin_amdgcn_readfirstlane(kdst+(slot)))
  #define DMA_V(t,slot) glds16(vsrc+(long)(t)*KVBLK*DM,(unsigned)__builtin_amdgcn_readfirstlane(vdst+(slot)))
  const int vb0=(int)(lds0+LDS_V)+((lane>>4)&1)*32+(lane&3)*8+(4*hi+((lane&15)>>2))*64;
  const char*Kbase=shm+LDS_K; bf16x8 kf[8];
  const lds_cptr shm3=(lds_cptr)shm; const lds_cptr kp0=shm3+LDS_K+hi*1024+r32*16; const lds_cptr vp0=shm3+LDS_V+((lane>>4)&1)*32+(lane&3)*8+(4*hi+((lane&15)>>2))*64;
  DMA_K(0,0);DMA_V(0,0);DMA_K(1,SLOTB);
  bf16x8 qr[4];
  #pragma unroll
  for(int d0=0;d0<4;++d0)qr[d0]=*reinterpret_cast<const bf16x8*>(&Qw[(long)r32*DM+d0*16+hi*8]);
  float mhat=0.f,l_reg=0.f;f32x16 o[2];o[0]=f32x16{};o[1]=f32x16{};f32x16 negm=f32x16{};asm volatile("":"+v"(negm));
  const float qk0=(float)(q0+wid*QBLK+r32-4*hi-T0*KVBLK);
  #define CMASK(P0,P1,t) do{ if(BIAS==1){ const float dl_=qk0-(float)(64*(t)); \
      _Pragma("unroll") for(int r=0;r<16;++r){ const float c_=(float)((r&3)+8*(r>>2)); P0[r]=__builtin_fmaf(-slope2,__builtin_fabsf(dl_-c_),P0[r]); P1[r]=__builtin_fmaf(-slope2,__builtin_fabsf(dl_-(c_+32.f)),P1[r]); } } }while(0)
  bool resc=false;
  #define START(P0,P1) do{ const float rm=rowmax(P0,P1); resc=false; \
    { const float dl=rm; mhat=fadd_s(mhat,dl); \
      _Pragma("unroll") for(int r=0;r<16;++r){P0[r]=fsub_s(P0[r],dl);P1[r]=fsub_s(P1[r],dl);} \
      _Pragma("unroll") for(int r=0;r<16;++r)negm[r]=-mhat; asm volatile("":"+v"(negm)); } \
    _Pragma("unroll") for(int r=0;r<16;++r)P0[r]=__builtin_amdgcn_exp2f(P0[r]); }while(0)
  #define RESC() do{ if(resc){ asm volatile("s_waitcnt lgkmcnt(0)":::"memory"); \
      _Pragma("unroll") for(int d_=0;d_<2;++d_) _Pragma("unroll") for(int r=0;r<16;++r)o[d_][r]*=wsf[crow(r,hi)]; } }while(0)
  f32x16 pA0,pA1,pB0,pB1;
  int sl_prev=0,sl_cur=0,sl_next=SLOTB;
  #define ROT() do{sl_prev=sl_cur;sl_cur=sl_next;sl_next=(sl_next==(NSLOT-1)*SLOTB)?0:sl_next+SLOTB;}while(0)
  DMA_K(2,2*SLOTB);
  WAIT_BAR(3);
  qkt(pA0,pA1,Kbase,qr,negm,r32,hi);asm volatile("s_nop 15\n\ts_nop 7":"+v"(pA0),"+v"(pA1));CMASK(pA0,pA1,0);
  START(pA0,pA1);
  _Pragma("unroll") for(int r=0;r<16;++r)pA1[r]=__builtin_amdgcn_exp2f(pA1[r]);
  WAIT_BAR(0);
  DMA_K(3,0);DMA_V(1,SLOTB);
  ROT();
  kload8(kf,kp0+sl_cur);
  WAIT_BAR(2);
  s16x4 vlo[8],vhi[8]; u32x4 pw0,pw1,pw2,pw3;
  #define PKW(P,B) cvtpk_s(P[B],P[B+1])
  #define PAF(k) __builtin_bit_cast(bf16x8,pw##k)
  #define VFR(i) (bf16x8){vlo[i][0],vlo[i][1],vlo[i][2],vlo[i][3],vhi[i][0],vhi[i][1],vhi[i][2],vhi[i][3]}
  #define PIN(x) asm volatile("":"+v"(x))
  #define MX3(a,b,c) __builtin_fmaxf(__builtin_fmaxf((a),(b)),(c))
  #define GAPA(MF,A0,A1,A2,A3,W0,W1,PW) do{ MF; sacc+=A0; sacc+=A1; sacc+=A2; sacc+=A3; PIN(sacc); W0; W1; PIN(PW); SBAR(); }while(0)
  #define EX(v) __builtin_amdgcn_exp2f(v)
  #define GAPB(MF,X,B) do{ MF; X[B]=EX(X[B]); X[B+1]=EX(X[B+1]); X[B+2]=EX(X[B+2]); X[B+3]=EX(X[B+3]); PIN(X); SBAR(); }while(0)
  #define VRD(i) do{ vlo[i]=vtr(vp_+(((i)>>2)*4096+((i)&3)*1024)); vhi[i]=vtr(vp_+(((i)>>2)*4096+((i)&3)*1024+512)); }while(0)
  #define KRD(G,j) do{ if(G){ kload2(kf,kp0+sl_next,j); SBAR(); } }while(0)
  #define STEP(C0,C1,P0,P1,t,GK,GV,GL) do{ SBAR(); \
    const lds_cptr vp_=vp0+sl_prev; \
    VRD(0); SBAR(); float sacc=(P0[0]+P0[1]); \
    GAPA(C0=__builtin_amdgcn_mfma_f32_32x32x16_bf16(kf[0],qr[0],negm,0,0,0), P0[2],P0[3],P0[4],P0[5],     pw0[0]=PKW(P0,0), pw0[1]=PKW(P0,2), pw0); \
    VRD(4); SBAR(); GAPA(C1=__builtin_amdgcn_mfma_f32_32x32x16_bf16(kf[1],qr[0],negm,0,0,0), P0[6],P0[7],P0[8],P0[9],     pw0[2]=PKW(P0,4), pw0[3]=PKW(P0,6), pw0); \
    VRD(1); SBAR(); GAPA(C0=__builtin_amdgcn_mfma_f32_32x32x16_bf16(kf[2],qr[1],C0,0,0,0),   P0[10],P0[11],P0[12],P0[13], pw1[0]=PKW(P0,8), pw1[1]=PKW(P0,10), pw1); \
    VRD(5); SBAR(); GAPA(C1=__builtin_amdgcn_mfma_f32_32x32x16_bf16(kf[3],qr[1],C1,0,0,0),   P0[14],P0[15],P1[0],P1[1],   pw1[2]=PKW(P0,12),pw1[3]=PKW(P0,14), pw1); \
    VRD(2); SBAR(); GAPA(C0=__builtin_amdgcn_mfma_f32_32x32x16_bf16(kf[4],qr[2],C0,0,0,0),   P1[2],P1[3],P1[4],P1[5],     pw2[0]=PKW(P1,0), pw2[1]=PKW(P1,2), pw2); \
    VRD(6); SBAR(); GAPA(C1=__builtin_amdgcn_mfma_f32_32x32x16_bf16(kf[5],qr[2],C1,0,0,0),   P1[6],P1[7],P1[8],P1[9],     pw2[2]=PKW(P1,4), pw2[3]=PKW(P1,6), pw2); \
    VRD(3); SBAR(); GAPA(C0=__builtin_amdgcn_mfma_f32_32x32x16_bf16(kf[6],qr[3],C0,0,0,0),   P1[10],P1[11],P1[12],P1[13], pw3[0]=PKW(P1,8), pw3[1]=PKW(P1,10), pw3); \
    VRD(7); SBAR(); GAPA(C1=__builtin_amdgcn_mfma_f32_32x32x16_bf16(kf[7],qr[3],C1,0,0,0),   P1[14],P1[15],0.f,0.f,       pw3[2]=PKW(P1,12),pw3[3]=PKW(P1,14), pw3); \
    l_reg+=sacc; \
    if(GK){DMA_K((t)+3,sl_cur);} if(GV){DMA_V((t)+1,sl_next);} \
    CMASK(C0,C1,t); \
    { float a=MX3(C0[0],C0[1],C1[0]),b=MX3(C0[2],C0[3],C1[1]); a=MX3(a,C1[2],C1[3]); \
      _Pragma("unroll") for(int r=4;r<16;r+=4){a=MX3(a,C0[r],C0[r+1]);b=MX3(b,C0[r+2],C0[r+3]);a=MX3(a,C1[r],C1[r+1]);b=MX3(b,C1[r+2],C1[r+3]);} \
      float rm=__builtin_fmaxf(a,b); { auto rr=__builtin_amdgcn_permlane32_swap(__float_as_uint(rm),__float_as_uint(rm),false,false); rm=__builtin_fmaxf(__uint_as_float(rr[0]),__uint_as_float(rr[1])); } \
      resc=false; \
      if(__builtin_expect(__any(rm>(float)THRL),0)){ const float dl=__builtin_fmaxf(rm,0.f); mhat+=dl; \
        _Pragma("unroll") for(int r=0;r<16;++r){C0[r]-=dl;C1[r]-=dl;} \
        _Pragma("unroll") for(int r=0;r<16;++r)negm[r]=-mhat; asm volatile("":"+v"(negm)); \
        const float f=__builtin_amdgcn_exp2f(-dl); l_reg*=f; if(hi==0)wsf[r32]=f; resc=true; } } \
    SBAR(); \
    GAPB(o[0]=__builtin_amdgcn_mfma_f32_32x32x16_bf16(PAF(0),VFR(0),o[0],0,0,0), C0,0); \
    GAPB(o[1]=__builtin_amdgcn_mfma_f32_32x32x16_bf16(PAF(0),VFR(4),o[1],0,0,0), C0,4); \
    KRD(GL,0); GAPB(o[0]=__builtin_amdgcn_mfma_f32_32x32x16_bf16(PAF(1),VFR(1),o[0],0,0,0), C0,8); \
    KRD(GL,1); GAPB(o[1]=__builtin_amdgcn_mfma_f32_32x32x16_bf16(PAF(1),VFR(5),o[1],0,0,0), C0,12); \
    KRD(GL,2); GAPB(o[0]=__builtin_amdgcn_mfma_f32_32x32x16_bf16(PAF(2),VFR(2),o[0],0,0,0), C1,0); \
    KRD(GL,3); GAPB(o[1]=__builtin_amdgcn_mfma_f32_32x32x16_bf16(PAF(2),VFR(6),o[1],0,0,0), C1,4); \
    GAPB(o[0]=__builtin_amdgcn_mfma_f32_32x32x16_bf16(PAF(3),VFR(3),o[0],0,0,0), C1,8); \
    GAPB(o[1]=__builtin_amdgcn_mfma_f32_32x32x16_bf16(PAF(3),VFR(7),o[1],0,0,0), C1,12); \
    }while(0)
  int t=1;
  for(;t+5<NT;t+=2){
    STEP(pB0,pB1,pA0,pA1,t,true,true,true);     WAIT_BAR(2); RESC(); ROT();
    STEP(pA0,pA1,pB0,pB1,t+1,true,true,true);   WAIT_BAR(2); RESC(); ROT();
  }
  #define ENDW(tt) do{ if((tt)+3<NT){WAIT_BAR(2);} else if((tt)+2<NT){WAIT_BAR(1);} else {WAIT_BAR(0);} }while(0)
  for(;t+1<NT;t+=2){
    STEP(pB0,pB1,pA0,pA1,t,(t+3<NT),(t+1<NT),(t+1<NT));       ENDW(t);   RESC(); ROT();
    STEP(pA0,pA1,pB0,pB1,t+1,(t+4<NT),(t+2<NT),(t+2<NT));     ENDW(t+1); RESC(); ROT();
  }
  STEP(pB0,pB1,pA0,pA1,NT-1,false,false,false); RESC();
  { float sacc=pB0[0]+pB0[1]; _Pragma("unroll") for(int r=2;r<16;++r)sacc+=pB0[r]; _Pragma("unroll") for(int r=0;r<16;++r)sacc+=pB1[r]; l_reg+=sacc;
    pw0=(u32x4){PKW(pB0,0),PKW(pB0,2),PKW(pB0,4),PKW(pB0,6)};pw1=(u32x4){PKW(pB0,8),PKW(pB0,10),PKW(pB0,12),PKW(pB0,14)};pw2=(u32x4){PKW(pB1,0),PKW(pB1,2),PKW(pB1,4),PKW(pB1,6)};pw3=(u32x4){PKW(pB1,8),PKW(pB1,10),PKW(pB1,12),PKW(pB1,14)};
    SBAR(); pv(o,vb0+sl_cur,PAF(0),PAF(1),PAF(2),PAF(3)); }
  #undef PKW
  #undef PAF
  #undef VFR
  #undef PIN
  #undef MX3
  #undef GAPA
  #undef GAPB
  #undef EX
  #undef VRD
  #undef KRD
  #undef STEP
  #undef ENDW
  {auto rr=__builtin_amdgcn_permlane32_swap(__float_as_uint(l_reg),__float_as_uint(l_reg),false,false);l_reg=__uint_as_float(rr[0])+__uint_as_float(rr[1]);}
  if(hi==0)wsf[32+r32]=l_reg;asm volatile("s_waitcnt lgkmcnt(0)":::"memory");
  float rli[16];
  #pragma unroll
  for(int r=0;r<16;++r)rli[r]=__builtin_amdgcn_rcpf(wsf[32+crow(r,hi)]);
  if(OUTF32){ float*Ow=(float*)O+(rowbase+q0+wid*QBLK)*(long)opitch;
    #pragma unroll
    for(int r=0;r<16;++r){const int orow=crow(r,hi);
      #pragma unroll
      for(int d0=0;d0<2;++d0)Ow[(long)orow*opitch+d0*32+r32]=o[d0][r]*rli[r];}
  } else { bf16*Ow=(bf16*)O+(rowbase+q0+wid*QBLK)*(long)opitch;
    bf16*stg=(bf16*)(shm+LDS_OST)+wid*2048;
    #pragma unroll
    for(int r=0;r<16;++r){const int orow=crow(r,hi);
      #pragma unroll
      for(int d0=0;d0<2;++d0)stg[orow*64+d0*32+r32]=__float2bfloat16(o[d0][r]*rli[r]);}
    asm volatile("s_waitcnt lgkmcnt(0)":::"memory");
    #pragma unroll
    for(int i=0;i<4;++i){const int row=i*8+(lane>>3),ch=lane&7; const u32x4 v=*(const u32x4*)(stg+row*64+ch*8); ATTN_STORE16(Ow+(long)row*opitch+ch*8,v);} }
  asm volatile("s_waitcnt lgkmcnt(0)\n\ts_barrier":::"memory");
  #undef DMA_K
  #undef DMA_V
  #undef CMASK
  #undef START
  #undef RESC
  #undef ROT
}
constexpr int ATTN_LDS_BYTES=LDS_BYTES;
#undef SBAR
#undef WAIT_BAR
}
#ifndef PG8_SP2
#define PG8_SP2 true
#endif
#ifndef PG8_ALIGN
#define PG8_ALIGN true
#endif
namespace cg = cooperative_groups;

constexpr int NB = 8, S = 4096, M = NB * S, D = 1024, NIN = 2560, FF = 4096, DEPTH = 2;
constexpr int PITCH = NIN;
constexpr float EPS = 1e-6f;
constexpr float LOG2E = 1.4426950408889634f;
constexpr float C2 = 0.125f * LOG2E;
constexpr int C_AQ = 0, C_AK = 512, C_AV = 1024, C_BQ = 1536, C_BK = 1792, C_BV = 1920, C_CQ = 2048, C_CK = 2304, C_CV = 2432;
constexpr int MX_A = 0, MX_B = 512, MX_C = 768;

constexpr size_t MiB = 1u << 20;
constexpr size_t WS_CTL = 0, CTL_ZERO_BYTES = 1 * MiB;
constexpr size_t WS_TRIG = 1 * MiB;
constexpr size_t WS_WIN = 2 * MiB, WS_WOUT = 12 * MiB, WS_W1 = 16 * MiB, WS_W2 = 32 * MiB;
constexpr size_t WS_XN = 48 * MiB;
constexpr size_t WS_Y = 112 * MiB;
constexpr size_t WS_PROJ = 240 * MiB;
constexpr size_t WS_MIX = 400 * MiB;
constexpr size_t WS_H = 240 * MiB;
constexpr size_t WS_END = 496 * MiB;
static_assert(WS_H + (size_t)M * FF * 2 <= WS_END && WS_MIX + (size_t)M * D * 2 <= WS_END && WS_PROJ + (size_t)M * NIN * 2 <= WS_MIX && WS_Y + (size_t)M * D * 4 <= WS_PROJ && WS_XN + (size_t)M * D * 2 <= WS_Y, "ws map");

constexpr int NWAVES = 8;
constexpr int LDS_BYTES = 147456;
#define LAS __attribute__((address_space(3)))
typedef unsigned short bf16;
typedef float f32x4 __attribute__((ext_vector_type(4)));
typedef float f32x16 __attribute__((ext_vector_type(16)));
typedef short bf16x8 __attribute__((ext_vector_type(8)));
typedef unsigned v4u __attribute__((ext_vector_type(4)));

__device__ __forceinline__ unsigned f2bf(float f) { unsigned u = __builtin_bit_cast(unsigned, f); return (u + 0x7fffu + ((u >> 16) & 1u)) >> 16; }
__device__ __forceinline__ unsigned pk2(float lo, float hi) { return f2bf(lo) | (f2bf(hi) << 16); }
__device__ __forceinline__ float bf2f(unsigned short h) { return __builtin_bit_cast(float, (unsigned)h << 16); }
__device__ __forceinline__ float wave_sum(float v) {
#pragma unroll
    for (int o = 1; o < 64; o <<= 1) v += __shfl_xor(v, o);
    return v;
}
__device__ __forceinline__ int crow(int r, int hi) { return (r & 3) + 8 * (r >> 2) + 4 * hi; }

#define GAS __attribute__((address_space(1)))
typedef GAS unsigned gu32;
#define RLX_AGENT __ATOMIC_RELAXED, __HIP_MEMORY_SCOPE_AGENT
constexpr int CW_NRM = 1024;
constexpr int CTL_WORDS = 65536;
constexpr int CW_BAR = 4096;
constexpr int RING_BYTES = 131072, LDSCTL_OFF = RING_BYTES, MISC_OFF = LDSCTL_OFF + 320;
#define XB_TMO      128
#define XB_XCNT(j)  (256  + 64 * (j))
#define XB_XSUB(j)  (1280 + 64 * (j))
#define XB_XGEN(j)  (2304 + 64 * (j))
#define XB_TOP      3328
#define XB_TOPGEN   3392
#define XCD_BAR_WORDS 3456
#define XB_SPIN_CAP (1u << 18)

__device__ __forceinline__ unsigned xb_ld(unsigned* p)              { return __hip_atomic_load(p, __ATOMIC_RELAXED, __HIP_MEMORY_SCOPE_AGENT); }
__device__ __forceinline__ unsigned xb_add(unsigned* p, unsigned v) { return __hip_atomic_fetch_add(p, v, __ATOMIC_RELAXED, __HIP_MEMORY_SCOPE_AGENT); }
__device__ __forceinline__ unsigned xb_xcc_id() { return (unsigned)__builtin_amdgcn_s_getreg((3 << 11) | 20) & 0xFu; }
#define XB_SPIN(cond, bar) do { unsigned _sp = 0; while (cond) { __builtin_amdgcn_s_sleep(1); \
    if ((++_sp & 255u) == 0u) { if (xb_ld(&(bar)[XB_TMO])) break; if (_sp > XB_SPIN_CAP) { atomicAdd(&(bar)[XB_TMO], 1u); break; } } } } while (0)

struct XcdBarrier {
    unsigned* bar; unsigned x;
    volatile LAS unsigned* st;
};

__device__ __forceinline__ XcdBarrier xcd_barrier_post(unsigned* bar, volatile LAS unsigned* st) {
    XcdBarrier b; b.bar = bar; b.x = xb_xcc_id(); b.st = st;
    if (threadIdx.x == 0) (void)xb_add(&bar[XB_XCNT(b.x)], 1u);
    return b;
}
__device__ __forceinline__ void xcd_barrier_complete(unsigned* bar, unsigned x, unsigned& nloc, unsigned& nx) {
    const unsigned G = gridDim.x * gridDim.y * gridDim.z;
    unsigned sum, cnt, mine, sp = 0u;
    for (;;) {
        sum = 0u; cnt = 0u; mine = 0u;
#pragma unroll
        for (unsigned j = 0; j < 16; ++j) { const unsigned c = xb_ld(&bar[XB_XCNT(j)]); sum += c; cnt += (c > 0u) ? 1u : 0u; mine = (j == x) ? c : mine; }
        if (sum == G) break;
        __builtin_amdgcn_s_sleep(1);
        if ((++sp & 255u) == 0u) { if (xb_ld(&bar[XB_TMO])) break; if (sp > XB_SPIN_CAP) { atomicAdd(&bar[XB_TMO], 1u); break; } }
    }
    nloc = mine > 0u ? mine : 1u; nx = cnt > 0u ? cnt : 1u;
}

__device__ __forceinline__ void xcd_barrier(const XcdBarrier& b) {
    asm volatile("s_waitcnt vmcnt(0)" ::: "memory");
    __syncthreads();
    if (threadIdx.x == 0) {
        unsigned* bar = b.bar;
        __builtin_amdgcn_s_waitcnt(0);
        unsigned nloc = b.st[0], nx = b.st[1];
        if (nloc == 0u) { xcd_barrier_complete(bar, b.x, nloc, nx); b.st[0] = nloc; b.st[1] = nx; }
        const unsigned old = xb_add(&bar[XB_XSUB(b.x)], 1u);
        const unsigned gen = old / nloc;
        if (old + 1u == (gen + 1u) * nloc) {
            __builtin_amdgcn_fence(__ATOMIC_RELEASE, "agent");
            asm volatile("s_waitcnt vmcnt(0)" ::: "memory");
            const unsigned og = xb_add(&bar[XB_TOP], 1u);
            const unsigned tg = og / nx;
            if (og + 1u == (tg + 1u) * nx) xb_add(&bar[XB_TOPGEN], 1u);
            else XB_SPIN(xb_ld(&bar[XB_TOPGEN]) == tg, bar);
            __builtin_amdgcn_fence(__ATOMIC_ACQUIRE, "agent");
            xb_add(&bar[XB_XGEN(b.x)], 1u);
            asm volatile("s_waitcnt vmcnt(0)" ::: "memory");
        } else {
            XB_SPIN(xb_ld(&bar[XB_XGEN(b.x)]) == gen, bar);
            __builtin_amdgcn_fence(__ATOMIC_ACQUIRE, "agent");
            asm volatile("s_waitcnt vmcnt(0)" ::: "memory");
        }
    }
    __syncthreads();
}

__device__ __forceinline__ void transpose_item(const float* W, int K, int N, bf16* WT, LAS float* scr, int item, int lane) {
    const int nblk = N / 32, kb = item / nblk, nb = item % nblk, k0 = 64 * kb, n0 = 32 * nb;
#pragma unroll 8
    for (int i = 0; i < 32; ++i) { const int kk = 2 * i + (lane >> 5); scr[kk * 33 + (lane & 31)] = W[(size_t)(k0 + kk) * N + n0 + (lane & 31)]; }
    asm volatile("s_waitcnt lgkmcnt(0)" ::: "memory");
    const int c = lane & 7;
#pragma unroll
    for (int j = 0; j < 4; ++j) { const int n = (lane >> 3) + 8 * j; const LAS float* s = scr + (8 * c) * 33 + n;
        v4u o; o.x = pk2(s[0 * 33], s[1 * 33]); o.y = pk2(s[2 * 33], s[3 * 33]); o.z = pk2(s[4 * 33], s[5 * 33]); o.w = pk2(s[6 * 33], s[7 * 33]);
        *(v4u*)(WT + (size_t)(n0 + n) * K + k0 + 8 * c) = o; }
    asm volatile("s_waitcnt lgkmcnt(0)" ::: "memory");
}
__device__ __forceinline__ void rms_row_to_bf16(const float* xrow, const float* g, bf16* orow, int lane) {
    const f32x4* xr = (const f32x4*)xrow + lane; const f32x4* gr = (const f32x4*)g + lane;
    f32x4 v[4]; float s = 0.f;
#pragma unroll
    for (int j = 0; j < 4; ++j) { v[j] = xr[64 * j]; s += (v[j].x * v[j].x + v[j].y * v[j].y) + (v[j].z * v[j].z + v[j].w * v[j].w); }
    const float rstd = 1.0f / sqrtf(wave_sum(s) * (1.f / D) + EPS);
    unsigned long long* o8 = (unsigned long long*)orow + lane;
#pragma unroll
    for (int j = 0; j < 4; ++j) { const f32x4 gg = gr[64 * j];
        o8[64 * j] = (unsigned long long)pk2(v[j].x * rstd * gg.x, v[j].y * rstd * gg.y) | ((unsigned long long)pk2(v[j].z * rstd * gg.z, v[j].w * rstd * gg.w) << 32); }
}
__device__ __forceinline__ void resnorm_row(const float* yrow, const float* baserow, float* outrow, const float* gpost, const float* gnext, bf16* xnrow, int lane) {
    const f32x4* yr = (const f32x4*)yrow + lane; const f32x4* br = (const f32x4*)baserow + lane; const f32x4* gp = (const f32x4*)gpost + lane;
    f32x4 v[4]; float s = 0.f;
#pragma unroll
    for (int j = 0; j < 4; ++j) { v[j] = yr[64 * j]; s += (v[j].x * v[j].x + v[j].y * v[j].y) + (v[j].z * v[j].z + v[j].w * v[j].w); }
    const float rstd = 1.0f / sqrtf(wave_sum(s) * (1.f / D) + EPS);
    float s2 = 0.f;
#pragma unroll
    for (int j = 0; j < 4; ++j) { const f32x4 b = br[64 * j], g = gp[64 * j]; v[j] = b + v[j] * rstd * g; s2 += (v[j].x * v[j].x + v[j].y * v[j].y) + (v[j].z * v[j].z + v[j].w * v[j].w); }
    f32x4* o = (f32x4*)outrow + lane;
#pragma unroll
    for (int j = 0; j < 4; ++j) o[64 * j] = v[j];
    if (gnext) {
        const float rstd2 = 1.0f / sqrtf(wave_sum(s2) * (1.f / D) + EPS);
        const f32x4* gn = (const f32x4*)gnext + lane; unsigned long long* o8 = (unsigned long long*)xnrow + lane;
#pragma unroll
        for (int j = 0; j < 4; ++j) { const f32x4 gg = gn[64 * j];
            o8[64 * j] = (unsigned long long)pk2(v[j].x * rstd2 * gg.x, v[j].y * rstd2 * gg.y) | ((unsigned long long)pk2(v[j].z * rstd2 * gg.z, v[j].w * rstd2 * gg.w) << 32); }
    }
}
__device__ __forceinline__ void cprep_row(bf16* prow, int pos, const float* gq, const float* gk, const float* trig, int lane) {
    const int idx = (lane < 32) ? (pos >> 6) : (pos & 63); const int fi = lane & 15;
    const float c = trig[idx * 16 + fi], sn = trig[1024 + idx * 16 + fi];
    const float gqv = gq[lane], gkv = gk[lane];
#pragma unroll
    for (int slot = 0; slot < 6; ++slot) {
        const int col = (slot < 4) ? (C_CQ + slot * 64) : (C_CK + (slot - 4) * 64);
        const float x = bf2f(prow[col + lane]);
        const float ss = wave_sum(x * x);
        const float xn = x * (1.0f / sqrtf(ss * (1.f / 64.f) + EPS)) * ((slot < 4) ? gqv : gkv);
        const float pr = __shfl_xor(xn, 16);
        float y = (lane & 16) ? (xn * c + pr * sn) : (xn * c - pr * sn);
        if (slot < 4) y *= C2;
        prow[col + lane] = (bf16)f2bf(y);
    }
}

template <int DV> __device__ __forceinline__ void attn_simple_unit(const bf16* __restrict__ P, int b, int qblk, int qcol, int kcol, int vcol, float slope2, bool window, float sink2,
                                                                   float* outf, bf16* outb, int opitch, int ocol, int lane) {
    const int r32 = lane & 31, hi = lane >> 5;
    const size_t rowbase = (size_t)b * S; const int q0 = qblk * 32; const int qpos = q0 + r32;
    bf16x8 qr[4];
#pragma unroll
    for (int d0 = 0; d0 < 4; ++d0) qr[d0] = *(const bf16x8*)(P + (rowbase + q0 + r32) * PITCH + qcol + d0 * 16 + hi * 8);
    int t_lo = 0, t_hi = S / 32;
    if (window) { int lo = q0 - 128; if (lo < 0) lo = 0; int hk = q0 + 32 + 128; if (hk > S) hk = S; t_lo = lo / 32; t_hi = hk / 32; }
    const float NEG = -INFINITY;
#define ATT_SCORES(p, t) do { p = f32x16{}; \
        _Pragma("unroll") for (int d0 = 0; d0 < 4; ++d0) { const bf16x8 kf = *(const bf16x8*)(P + (rowbase + (t) * 32 + r32) * PITCH + kcol + d0 * 16 + hi * 8); \
            p = __builtin_amdgcn_mfma_f32_32x32x16_bf16(kf, qr[d0], p, 0, 0, 0); } \
        _Pragma("unroll") for (int r = 0; r < 16; ++r) { const int kpos = (t) * 32 + crow(r, hi); int dist = qpos - kpos; dist = dist < 0 ? -dist : dist; \
            float v = p[r] - slope2 * (float)dist; if (window && dist > 128) v = NEG; p[r] = v; } } while (0)
    float m = NEG, l = 0.f;
    for (int t = t_lo; t < t_hi; ++t) {
        f32x16 p; ATT_SCORES(p, t);
        float tm = p[0];
#pragma unroll
        for (int r = 1; r < 16; ++r) tm = fmaxf(tm, p[r]);
        const float mn = fmaxf(m, tm); const float mref = (mn == NEG) ? 0.f : mn;
        float s = 0.f;
#pragma unroll
        for (int r = 0; r < 16; ++r) s += exp2f(p[r] - mref);
        l = l * exp2f(m - mref) + s; m = mn;
    }
    const float m2 = __shfl_xor(m, 32), l2 = __shfl_xor(l, 32);
    const float mn = fmaxf(fmaxf(m, m2), sink2);
    l = l * exp2f(m - mn) + l2 * exp2f(m2 - mn) + exp2f(sink2 - mn);
    const float rl = 1.0f / l;
    f32x16 o[DV / 32];
#pragma unroll
    for (int i = 0; i < DV / 32; ++i) o[i] = f32x16{};
    for (int t = t_lo; t < t_hi; ++t) {
        f32x16 p; ATT_SCORES(p, t);
#pragma unroll
        for (int r = 0; r < 16; ++r) p[r] = exp2f(p[r] - mn) * rl;
        bf16x8 pa[2];
#pragma unroll
        for (int s = 0; s < 2; ++s)
#pragma unroll
            for (int j = 0; j < 8; ++j) pa[s][j] = (short)f2bf(p[8 * s + j]);
#pragma unroll
        for (int db = 0; db < DV / 32; ++db)
#pragma unroll
            for (int s = 0; s < 2; ++s) { bf16x8 vf;
#pragma unroll
                for (int j = 0; j < 8; ++j) { const int key = t * 32 + 16 * s + 8 * (j >> 2) + 4 * hi + (j & 3); vf[j] = (short)P[(rowbase + key) * PITCH + vcol + db * 32 + r32]; }
                o[db] = __builtin_amdgcn_mfma_f32_32x32x16_bf16(pa[s], vf, o[db], 0, 0, 0); }
    }
#undef ATT_SCORES
#pragma unroll
    for (int db = 0; db < DV / 32; ++db)
#pragma unroll
        for (int r = 0; r < 16; ++r) { const size_t off = (rowbase + q0 + crow(r, hi)) * (size_t)opitch + ocol + db * 32 + r32;
            if (outf) outf[off] = o[db][r]; else outb[off] = (bf16)f2bf(o[db][r]); }
}

struct Args { const float* in[17]; float* out; unsigned char* ws; int ph_lo, ph_hi; };
enum { I_X = 0, I_WIN, I_WOUT, I_GPREMIX, I_GPOSTMIX, I_LQ1, I_LK1, I_LQ2, I_LK2, I_SUBLN, I_SINK, I_CQN, I_CKN, I_GPREMLP, I_GPOSTMLP, I_W1, I_W2 };
constexpr int PH_PER_LAYER = 9, N_PHASES = 1 + DEPTH * PH_PER_LAYER;

__global__ void __launch_bounds__(NWAVES * 64, 2) fwd(Args args) {
    extern __shared__ __attribute__((aligned(16))) unsigned char lds_raw[];
    LAS unsigned char* lds = (LAS unsigned char*)lds_raw;
    cg::grid_group grid = cg::this_grid();
    for (int u = threadIdx.x; u < (LDS_BYTES - LDSCTL_OFF) / 4; u += NWAVES * 64) ((LAS unsigned*)(lds + LDSCTL_OFF))[u] = 0u;
    __syncthreads();
    for (int ph = args.ph_lo; ph < args.ph_hi; ++ph) {
        int tid_ = threadIdx.x; asm volatile("" : "+v"(tid_));
        size_t zoff_ = 0; asm volatile("" : "+s"(zoff_));
        unsigned char* ws = args.ws + zoff_;
        const int tid = tid_, lane = tid & 63, wave = __builtin_amdgcn_readfirstlane(tid >> 6);
        const int G = gridDim.x; const int bx = blockIdx.x; const int vcu = (G % 8 == 0) ? (bx % 8) * (G / 8) + bx / 8 : bx;
        const int gw = vcu * NWAVES + wave, NGW = G * NWAVES;
        const float* x = args.in[I_X]; float* out = args.out;
        float* trig = (float*)(ws + WS_TRIG);
        bf16* Win_t = (bf16*)(ws + WS_WIN); bf16* Wout_t = (bf16*)(ws + WS_WOUT); bf16* W1_t = (bf16*)(ws + WS_W1); bf16* W2_t = (bf16*)(ws + WS_W2);
        bf16* XN = (bf16*)(ws + WS_XN); float* Y = (float*)(ws + WS_Y); float* OA = (float*)(ws + WS_Y);
        bf16* PROJ = (bf16*)(ws + WS_PROJ); bf16* MIX = (bf16*)(ws + WS_MIX); bf16* HB = (bf16*)(ws + WS_H);
        if (ph == 0) {
            if (bx == 0) for (int i = tid; i < CTL_WORDS; i += NWAVES * 64) __hip_atomic_store((unsigned*)ws + i, 0u, __ATOMIC_RELAXED, __HIP_MEMORY_SCOPE_AGENT);
            if (bx == 0) for (int i = tid; i < 1024; i += NWAVES * 64) { const int idx = i >> 4, k = i & 15;
                const float freq = exp2f(-(float)(2 * k) * (1.f / 32.f) * 13.287712379549449f);
                const float ang = (float)idx * freq; trig[i] = cosf(ang); trig[1024 + i] = sinf(ang); }
            LAS float* scr = (LAS float*)(lds + wave * 16384);
            constexpr int I_IN = (D / 64) * (NIN / 32), I_OUT = (D / 64) * (D / 32), I_1 = (D / 64) * (FF / 32), I_2 = (FF / 64) * (D / 32), I_LAYER = I_IN + I_OUT + I_1 + I_2;
            for (int it = gw; it < DEPTH * I_LAYER; it += NGW) {
                const int l = it / I_LAYER; int r = it % I_LAYER;
                if (r < I_IN) { transpose_item(args.in[I_WIN] + (size_t)l * D * NIN, D, NIN, Win_t + (size_t)l * NIN * D, scr, r, lane); continue; } r -= I_IN;
                if (r < I_OUT) { transpose_item(args.in[I_WOUT] + (size_t)l * D * D, D, D, Wout_t + (size_t)l * D * D, scr, r, lane); continue; } r -= I_OUT;
                if (r < I_1) { transpose_item(args.in[I_W1] + (size_t)l * D * FF, D, FF, W1_t + (size_t)l * FF * D, scr, r, lane); continue; } r -= I_1;
                transpose_item(args.in[I_W2] + (size_t)l * FF * D, FF, D, W2_t + (size_t)l * D * FF, scr, r, lane);
            }
            for (int m = gw; m < M; m += NGW) rms_row_to_bf16(x + (size_t)m * D, args.in[I_GPREMIX], XN + (size_t)m * D, lane);
            asm volatile("s_waitcnt vmcnt(0) lgkmcnt(0)" ::: "memory"); __syncthreads();
        } else {
            const int l = (ph - 1) / PH_PER_LAYER, sub = (ph - 1) % PH_PER_LAYER;
            switch (sub) {
            case 0: {
                pg8::Gemm g{XN, Win_t + (size_t)l * NIN * D, M, NIN, D}; pg8::StaticOrder So; So.init(M, NIN, G, bx);
                pg8::EpiBf16<0> E{PROJ, NIN, (1u << 0) | (1u << 1) | (1u << 6), C2};
                pg8::gemm_phase<pg8::EpiBf16<0>, pg8::StaticOrder, PG8_ALIGN, PG8_SP2>(lds, g, So, E);
            } break;
            case 1: {
                const float* gq = args.in[I_CQN] + l * 64; const float* gk = args.in[I_CKN] + l * 64;
                const int R = (M + NGW - 1) / NGW;
                float nq[8], nk[8];
#pragma unroll
                for (int sl = 0; sl < 8; ++sl) { nq[sl] = 0.f; nk[sl] = 0.f; }
                int bcur = -1;
                unsigned* nrm = (unsigned*)ws + CW_NRM + l * 128;
                for (int m = gw * R; m < (gw + 1) * R && m < M; ++m) {
                    const int bb = m / S;
                    if (bb != bcur) { if (bcur >= 0 && lane < 16) { const int sl = lane >> 1; float v = (lane & 1) ? nk[0] : nq[0];
#pragma unroll
                            for (int q = 1; q < 8; ++q) if (sl == q) v = (lane & 1) ? nk[q] : nq[q];
                            atomicMax(nrm + bcur * 16 + lane, __float_as_uint(v)); }
#pragma unroll
                        for (int sl = 0; sl < 8; ++sl) { nq[sl] = 0.f; nk[sl] = 0.f; }
                        bcur = bb; }
                    bf16* prow = PROJ + (size_t)m * PITCH;
#pragma unroll
                    for (int sl = 0; sl < 8; ++sl) { const float qv = bf2f(prow[C_AQ + sl * 64 + lane]), kv = bf2f(prow[C_AK + sl * 64 + lane]);
                        nq[sl] = fmaxf(nq[sl], wave_sum(qv * qv)); nk[sl] = fmaxf(nk[sl], wave_sum(kv * kv)); }
                    cprep_row(prow, m % S, gq, gk, trig, lane);
                }
                if (bcur >= 0 && lane < 16) { const int sl = lane >> 1; float v = (lane & 1) ? nk[0] : nq[0];
#pragma unroll
                    for (int q = 1; q < 8; ++q) if (sl == q) v = (lane & 1) ? nk[q] : nq[q];
                    atomicMax(nrm + bcur * 16 + lane, __float_as_uint(v)); }
            } break;
            case 2: {
                constexpr int NQ = S / 32;
                constexpr int UA = 0, UB = NB * 4 * NQ, UC = 0;
                for (int u = vcu; u < NB * 4 * 2 * 2 * 16; u += G) { const int round = u >> 8, rem = u & 255, b = rem >> 5, j = rem & 31, vh = j >> 4, h = round >> 1, map = round & 1, qb = ((j & 15) + 8 * map) & 15;
                    const float slope2 = exp2f(-(float)(2 * h + 1)) * LOG2E;
                    const unsigned* nrm = (const unsigned*)ws + CW_NRM + l * 128 + b * 16 + (h * 2 + map) * 2;
                    const float qk = sqrtf(__uint_as_float(__hip_atomic_load(nrm, __ATOMIC_RELAXED, __HIP_MEMORY_SCOPE_AGENT)) * __uint_as_float(__hip_atomic_load(nrm + 1, __ATOMIC_RELAXED, __HIP_MEMORY_SCOPE_AGENT)));
                    const float dsk = (2.f * qk + 40.f) / slope2;
                    int T0 = 0, T1 = S / 64;
                    if (dsk < (float)S) { const int ds = (int)dsk + 1, q0 = qb * 256; const int lo = q0 - ds, hk = q0 + 256 + ds; T0 = lo > 0 ? lo / 64 : 0; T1 = hk < S ? (hk + 63) / 64 : S / 64;
                        if ((T1 - T0) & 1) { if (T1 < S / 64) ++T1; else --T0; } }
                    T0 = __builtin_amdgcn_readfirstlane(T0); T1 = __builtin_amdgcn_readfirstlane(T1);
                    attn_body::attn_unit<8, 1, true>(b, qb, (const attn_body::bf16*)(PROJ + C_AQ + h * 128 + map * 64), (const attn_body::bf16*)(PROJ + C_AK + h * 128 + map * 64), (const attn_body::bf16*)(PROJ + C_AV + h * 128 + vh * 64),
                                                     slope2, OA + (size_t)map * M * 512 + h * 128 + vh * 64, 512, (char*)lds_raw, T0, T1 - T0); }
                for (int u = vcu; u < NB * 4 * 16; u += G) { const int round = u >> 8, rem = u & 255, b = rem >> 5, j = rem & 31, qb = j & 15, h = round * 2 + (j >> 4);
                    attn_body::attn_unit<8, 0, false>(b, qb, (const attn_body::bf16*)(PROJ + C_CQ + h * 64), (const attn_body::bf16*)(PROJ + C_CK + (h >> 1) * 64), (const attn_body::bf16*)(PROJ + C_CV + (h >> 1) * 64),
                                                      0.f, MIX + MX_C + h * 64, D, (char*)lds_raw, 0, S / 64); }
                for (int u = gw; u < UA + UB + UC; u += NGW) {
                    if (u < UA) { const int qb = u % NQ, s = u / NQ, map = s & 1, h = (s >> 1) & 3, b = s >> 3;
                        attn_simple_unit<128>(PROJ, b, qb, C_AQ + h * 128 + map * 64, C_AK + h * 128 + map * 64, C_AV + h * 128, exp2f(-(float)(2 * h + 1)) * LOG2E, false, -INFINITY,
                                              OA + (size_t)map * M * 512, nullptr, 512, h * 128, lane);
                    } else if (u < UA + UB) { const int v = u - UA; const int qb = v % NQ, s = v / NQ, h = s & 3, b = s >> 2;
                        attn_simple_unit<64>(PROJ, b, qb, C_BQ + h * 64, C_BK + (h >> 1) * 64, C_BV + (h >> 1) * 64, exp2f(-(float)(2 * h + 2)) * LOG2E, true, args.in[I_SINK][l * 4 + h] * LOG2E,
                                             nullptr, MIX, D, MX_B + h * 64, lane);
                    } else { const int v = u - UA - UB; const int qb = v % NQ, s = v / NQ, h = s & 3, b = s >> 2;
                        attn_simple_unit<64>(PROJ, b, qb, C_CQ + h * 64, C_CK + (h >> 1) * 64, C_CV + (h >> 1) * 64, 0.f, false, -INFINITY,
                                             nullptr, MIX, D, MX_C + h * 64, lane);
                    }
                }
            } break;
            case 3: {
                const float lam_init = 0.8f - 0.6f * expf(-0.3f * (float)l);
                const float d1 = wave_sum(args.in[I_LQ1][l * 64 + lane] * args.in[I_LK1][l * 64 + lane]);
                const float d2 = wave_sum(args.in[I_LQ2][l * 64 + lane] * args.in[I_LK2][l * 64 + lane]);
                const float lam = expf(d1) - expf(d2) + lam_init;
                const float g0 = args.in[I_SUBLN][l * 128 + 2 * lane] * (1.f - lam_init), g1 = args.in[I_SUBLN][l * 128 + 2 * lane + 1] * (1.f - lam_init);
                for (int it = gw; it < M * 4; it += NGW) { const int m = it >> 2, h = it & 3; const size_t off = (size_t)m * 512 + h * 128 + 2 * lane;
                    const float2 a = *(const float2*)(OA + off), c = *(const float2*)(OA + (size_t)M * 512 + off);
                    const float o0 = a.x - lam * c.x, o1 = a.y - lam * c.y;
                    const float rstd = 1.0f / sqrtf(wave_sum(o0 * o0 + o1 * o1) * (1.f / 128.f) + EPS);
                    *(unsigned*)(MIX + (size_t)m * D + MX_A + h * 128 + 2 * lane) = pk2(o0 * rstd * g0, o1 * rstd * g1); }
            } break;
            case 4: {
                pg8::Gemm g{MIX, Wout_t + (size_t)l * D * D, M, D, D}; pg8::StaticOrder So; So.init(M, D, G, bx);
                pg8::EpiF32 E{Y, D};
                pg8::gemm_phase<pg8::EpiF32, pg8::StaticOrder, PG8_ALIGN, PG8_SP2>(lds, g, So, E);
            } break;
            case 5: {
                const float* base = (l == 0) ? x : out;
                for (int m = gw; m < M; m += NGW) resnorm_row(Y + (size_t)m * D, base + (size_t)m * D, out + (size_t)m * D, args.in[I_GPOSTMIX] + l * D, args.in[I_GPREMLP] + l * D, XN + (size_t)m * D, lane);
            } break;
            case 6: {
                pg8::Gemm g{XN, W1_t + (size_t)l * FF * D, M, FF, D}; pg8::StaticOrder So; So.init(M, FF, G, bx);
                pg8::EpiBf16<1> E{HB, FF, 0u, 1.f};
                pg8::gemm_phase<pg8::EpiBf16<1>, pg8::StaticOrder, PG8_ALIGN, PG8_SP2>(lds, g, So, E);
            } break;
            case 7: {
                pg8::Gemm g{HB, W2_t + (size_t)l * D * FF, M, D, FF}; pg8::StaticOrder So; So.init(M, D, G, bx);
                pg8::EpiF32 E{Y, D};
                pg8::gemm_phase<pg8::EpiF32, pg8::StaticOrder, PG8_ALIGN, PG8_SP2>(lds, g, So, E);
            } break;
            default: {
                const float* gnext = (l + 1 < DEPTH) ? args.in[I_GPREMIX] + (l + 1) * D : nullptr;
                for (int m = gw; m < M; m += NGW) resnorm_row(Y + (size_t)m * D, out + (size_t)m * D, out + (size_t)m * D, args.in[I_GPOSTMLP] + l * D, gnext, XN + (size_t)m * D, lane);
            } break;
            }
        }
        if (ph + 1 < args.ph_hi) {
            if (ph == args.ph_lo) { grid.sync();
                (void)xcd_barrier_post((unsigned*)args.ws + CW_BAR, (volatile LAS unsigned*)(lds + MISC_OFF) + 8); }
            else { XcdBarrier xb; xb.bar = (unsigned*)args.ws + CW_BAR; xb.x = xb_xcc_id(); xb.st = (volatile LAS unsigned*)(lds + MISC_OFF) + 8; xcd_barrier(xb); }
        }
    }
}

#ifndef MK_ONE_LAUNCH
#define MK_ONE_LAUNCH 1
#endif
extern "C" void kernel_launch(void* const* d_in, const int* in_sizes, int n_in, void* d_out, int out_size, void* d_ws, size_t ws_size, hipStream_t stream) {
    static int grid = 0;
    if (grid == 0) {
        if (n_in != 17 || in_sizes[0] != M * D || out_size != M * D || ws_size < WS_END) { fprintf(stderr, "kernel_launch: unexpected shapes (n_in %d, in0 %d, out %d, ws %zu); nothing launched\n", n_in, n_in > 0 ? in_sizes[0] : -1, out_size, ws_size); grid = -1; return; }
        int dev = 0, cus = 0, per_cu = 0;
        if (hipGetDevice(&dev) != hipSuccess || hipDeviceGetAttribute(&cus, hipDeviceAttributeMultiprocessorCount, dev) != hipSuccess) { grid = -1; return; }
        if (hipFuncSetAttribute((const void*)fwd, hipFuncAttributeMaxDynamicSharedMemorySize, LDS_BYTES) != hipSuccess) { fprintf(stderr, "kernel_launch: hipFuncSetAttribute failed\n"); grid = -1; return; }
        if (hipOccupancyMaxActiveBlocksPerMultiprocessor(&per_cu, (const void*)fwd, NWAVES * 64, LDS_BYTES) != hipSuccess || per_cu < 1) { fprintf(stderr, "kernel_launch: occupancy query says %d blocks per CU\n", per_cu); per_cu = 1; }
        (void)hipGetLastError();
        grid = cus;
    }
    if (grid < 0) return;
    Args a{};
    for (int i = 0; i < 17; ++i) a.in[i] = (const float*)d_in[i];
    a.out = (float*)d_out; a.ws = (unsigned char*)d_ws;
#if MK_ONE_LAUNCH
    a.ph_lo = 0; a.ph_hi = N_PHASES;
    void* kargs[] = {&a};
    hipError_t e = hipLaunchCooperativeKernel((const void*)fwd, dim3(grid), dim3(NWAVES * 64), kargs, LDS_BYTES, stream);
    if (e != hipSuccess) fprintf(stderr, "kernel_launch: cooperative launch failed: %s (grid %d)\n", hipGetErrorString(e), grid);
#else
    for (int ph = 0; ph < N_PHASES; ++ph) { a.ph_lo = ph; a.ph_hi = ph + 1;
        hipLaunchKernelGGL(fwd, dim3(grid), dim3(NWAVES * 64), LDS_BYTES, stream, a);
        const hipError_t le = hipPeekAtLastError();
        if (le != hipSuccess) { fprintf(stderr, "kernel_launch: launch %d failed: %s\n", ph, hipGetErrorName(le)); break; } }
#endif
}
```
